# Optimizing an MI355X kernel written in HIP

```python
import math
import jax
import jax.numpy as jnp
from jax import lax
import numpy as np


D_MODEL = 1024
BATCH = 8
SEQ = 2048
DEPTH = 2

GRID_W = 64
CTX_LEN = 256

NA_HEADS = 8
NA_HEAD_DIM = 64
NA_W = NA_HEADS * NA_HEAD_DIM
NA_KH = 8
NA_KW = 16

HY_W = 256
HY_ORDER = 2
HY_SHORT = 3
HY_BANDS = 8
HY_EMB = 1 + 2 * HY_BANDS
HY_FFN = 64
HY_FAST_DECAY = 0.3
HY_SLOW_DECAY = 1.5
HY_TARGET = 1e-2

RET_HEADS = 4
RET_HEAD_DIM = 64
RET_W = RET_HEADS * RET_HEAD_DIM
RET_CHUNK = 128

MIX_W = NA_W + HY_W + RET_W
IN_W = 4 * NA_W + 4 * HY_W + 4 * RET_W
ROPE_BASE = 10000.0
EPS = 1e-6
NEG_INF = -1e30
F32 = jnp.float32

kernel_name = 'hybrid_na_hyena_retention_dit_block'


def rms_norm(x, eps=EPS):
    xf = x.astype(F32)
    return (xf * lax.rsqrt(jnp.mean(xf * xf, axis=-1, keepdims=True) + eps)).astype(x.dtype)


def ada_modulation(cond, ada_w, ada_b):
    return jax.nn.silu(cond) @ ada_w + ada_b


def modulate(h, mod, norm_w):
    shift, scale, gate = jnp.split(mod, 3, axis=-1)
    return rms_norm(h) * norm_w * (1 + scale) + shift, gate


def split_projection(u):
    sizes = (3 * NA_W, NA_W, 3 * HY_W, HY_W, 3 * RET_W, RET_W)
    cuts = [int(s) for s in np.cumsum(sizes)[:-1]]
    return jnp.split(u, cuts, axis=-1)


def heads(u, n_heads, head_dim):
    return u.reshape(u.shape[0], u.shape[1], n_heads, head_dim)


def na_queries(u_na, q_gain):
    q = heads(u_na[..., :NA_W], NA_HEADS, NA_HEAD_DIM)
    return rms_norm(q) * q_gain * (NA_HEAD_DIM ** -0.5)


def na_keys_values(u_na, k_gain):
    k = heads(u_na[..., NA_W:2 * NA_W], NA_HEADS, NA_HEAD_DIM)
    v = heads(u_na[..., 2 * NA_W:], NA_HEADS, NA_HEAD_DIM)
    return rms_norm(k) * k_gain, v


def neighborhood_attention(q, k, v, k_ctx, v_ctx, rpb):
    B, L, H, Dh = q.shape
    rows = L // GRID_W
    kh = min(NA_KH, rows)
    r = jnp.arange(rows)
    row_idx = jnp.clip(r - kh // 2, 0, rows - kh)[:, None] + jnp.arange(kh)[None, :]
    cq = jnp.arange(GRID_W)
    ck = jnp.arange(GRID_W)
    col_start = jnp.clip(cq - NA_KW // 2, 0, GRID_W - NA_KW)
    col_ok = (ck[None, :] >= col_start[:, None]) & (ck[None, :] < col_start[:, None] + NA_KW)
    dr = row_idx - r[:, None] + (NA_KH - 1)
    dc = jnp.clip(ck[None, :] - cq[:, None] + (NA_KW - 1), 0, 2 * NA_KW - 2)
    bias = rpb[:, dr[:, None, :, None], dc[None, :, None, :]].astype(F32)

    qg = q.reshape(B, rows, GRID_W, H, Dh)
    kg = k.reshape(B, rows, GRID_W, H, Dh)[:, row_idx]
    vg = v.reshape(B, rows, GRID_W, H, Dh)[:, row_idx]
    s_loc = jnp.einsum('brqhd,brjkhd->bhrqjk', qg, kg).astype(F32) + bias[None]
    s_loc = jnp.where(col_ok[:, None, :], s_loc, NEG_INF)
    s_ctx = jnp.einsum('brqhd,bchd->bhrqc', qg, k_ctx).astype(F32)
    n_loc = kh * GRID_W
    s = jnp.concatenate([s_loc.reshape(B, H, rows, GRID_W, n_loc), s_ctx], axis=-1)
    p = jax.nn.softmax(s, axis=-1).astype(v.dtype)
    p_loc = p[..., :n_loc].reshape(B, H, rows, GRID_W, kh, GRID_W)
    p_ctx = p[..., n_loc:]
    o = jnp.einsum('bhrqjk,brjkhd->brqhd', p_loc, vg) + jnp.einsum('bhrqc,bchd->brqhd', p_ctx, v_ctx)
    return o.reshape(B, L, H * Dh)


def context_attention(q, k, v):
    B, Lc, H, Dh = q.shape
    s = jnp.einsum('bqhd,bkhd->bhqk', q, k).astype(F32)
    p = jax.nn.softmax(s, axis=-1).astype(v.dtype)
    return jnp.einsum('bhqk,bkhd->bqhd', p, v).reshape(B, Lc, H * Dh)


def hyena_filter_spectrum(L, w1, b1, w2, b2, w3, sin_freq):
    t = jnp.linspace(0.0, 1.0, L, dtype=F32)[:, None]
    omega = 2.0 * math.pi * jnp.arange(L, dtype=F32)[:, None] / L
    bands = jnp.linspace(1e-4, HY_BANDS - 1, HY_BANDS, dtype=F32)[None, :]
    z = jnp.concatenate([t, jnp.cos(bands * omega), -jnp.sin(bands * omega)], axis=-1)
    h = jnp.sin(sin_freq[0] * (z @ w1 + b1))
    h = jnp.sin(sin_freq[1] * (h @ w2 + b2))
    h = (h @ w3).astype(F32).reshape(L, HY_ORDER, 2, HY_W)
    deltas = jnp.abs(jnp.linspace(math.log(HY_TARGET) / HY_SLOW_DECAY,
                                  math.log(HY_TARGET) / HY_FAST_DECAY, HY_W, dtype=F32))
    h = h * jnp.exp(-t * deltas)[:, None, None, :]
    h_fwd = h[:, :, 0]
    h_bwd = h[1:, :, 1][::-1]
    filt = jnp.concatenate([h_fwd, jnp.zeros((1, HY_ORDER, HY_W), F32), h_bwd], axis=0)
    filt = filt / jnp.sum(jnp.abs(filt), axis=0, keepdims=True)
    return jnp.fft.rfft(filt, axis=0)


def fft_long_conv(u, filt_f, skip):
    L = u.shape[1]
    uf = u.astype(F32)
    y = jnp.fft.irfft(jnp.fft.rfft(uf, n=2 * L, axis=1) * filt_f[None], n=2 * L, axis=1)[:, :L]
    return (y + uf * skip).astype(u.dtype)


def short_conv(u, w, b):
    L = u.shape[1]
    pad = HY_SHORT // 2
    up = jnp.pad(u, ((0, 0), (pad, pad), (0, 0)))
    return sum(up[:, j:j + L] * w[j] for j in range(HY_SHORT)) + b


def hyena_mixer(u, conv_w, conv_b, filt_f, skip):
    z = short_conv(u, conv_w, conv_b)
    v, x1, x2 = jnp.split(z, 3, axis=-1)
    y = x1 * fft_long_conv(v, filt_f[:, 0], skip[0])
    return x2 * fft_long_conv(y, filt_f[:, 1], skip[1])


def retention_heads(u):
    q, k, v = [heads(a, RET_HEADS, RET_HEAD_DIM).astype(F32) for a in jnp.split(u, 3, axis=-1)]
    return q, k * (RET_HEAD_DIM ** -0.5), v


def axial_rope(x):
    L, D = x.shape[1], x.shape[-1]
    half = D // 2
    quarter = half // 2
    t = jnp.arange(L)
    pos = jnp.stack([t // GRID_W, t % GRID_W], axis=0).astype(F32)
    freqs = ROPE_BASE ** (-jnp.arange(quarter, dtype=F32) / quarter)
    ang = pos[:, :, None] * freqs
    outs = []
    for a in range(2):
        xa = x[..., a * half:(a + 1) * half]
        x1, x2 = xa[..., :quarter], xa[..., quarter:]
        cos = jnp.cos(ang[a])[None, :, None, :]
        sin = jnp.sin(ang[a])[None, :, None, :]
        outs += [x1 * cos - x2 * sin, x1 * sin + x2 * cos]
    return jnp.concatenate(outs, axis=-1).astype(x.dtype)


def retention_chunks(q, k, v, log_gamma, state0):
    B, L, H, Dk = q.shape
    Dv = v.shape[-1]
    n = L // RET_CHUNK
    qc = q.reshape(B, n, RET_CHUNK, H, Dk)
    kc = k.reshape(B, n, RET_CHUNK, H, Dk)
    vc = v.reshape(B, n, RET_CHUNK, H, Dv)
    pos = jnp.arange(RET_CHUNK, dtype=F32)
    diff = pos[:, None] - pos[None, :]
    decay_in = jnp.where(diff >= 0, jnp.exp(log_gamma[:, None, None] * jnp.maximum(diff, 0.0)), 0.0)
    scores = jnp.einsum('bnjhd,bnlhd->bnhjl', qc, kc) * decay_in
    o = jnp.einsum('bnhjl,bnlhe->bnjhe', scores, vc)
    zeta = jnp.exp(log_gamma[:, None] * (RET_CHUNK - 1 - pos))
    chunk_kv = jnp.einsum('bnlhd,hl,bnlhe->nbhde', kc, zeta, vc)
    chunk_decay = jnp.exp(log_gamma * RET_CHUNK)[None, :, None, None]

    def step(state, kv):
        return chunk_decay * state + kv, state

    _, prev = lax.scan(step, state0, chunk_kv)
    xi = jnp.exp(log_gamma[:, None] * (pos + 1.0))
    o = o + jnp.einsum('bnjhd,nbhde,hj->bnjhe', qc, prev, xi)
    return o.reshape(B, L, H, Dv)


def bidir_retention(q, k, v, log_gamma, state_fwd, state_bwd):
    flip = lambda a: a[:, ::-1]
    o_fwd = retention_chunks(q, k, v, log_gamma[0], state_fwd)
    o_bwd = retention_chunks(flip(q), flip(k), flip(v), log_gamma[1], state_bwd)
    return o_fwd + flip(o_bwd)


def context_final_states(k, v, log_gamma):
    Lc = k.shape[1]
    pos = jnp.arange(Lc, dtype=F32)
    w_fwd = jnp.exp(log_gamma[0][:, None] * (Lc - 1 - pos))
    w_bwd = jnp.exp(log_gamma[1][:, None] * pos)
    s_fwd = jnp.einsum('bmhd,hm,bmhe->bhde', k, w_fwd, v)
    s_bwd = jnp.einsum('bmhd,hm,bmhe->bhde', k, w_bwd, v)
    return s_fwd, s_bwd


def merge_branches(a, g_a, y, g_y, r, g_r, w_out):
    B, L, _ = a.shape
    r = rms_norm(r).reshape(B, L, RET_W).astype(a.dtype)
    z = jnp.concatenate([a * jax.nn.silu(g_a), y * jax.nn.silu(g_y), r * jax.nn.silu(g_r)], axis=-1)
    return z @ w_out


def hybrid_layer(x, ctx, mod_x, mod_c, norm_w, w_in, w_out, q_gain, k_gain, rpb,
                 conv_w, conv_b, hw1, hb1, hw2, hb2, hw3, sin_freq, skip, ret_log_rate,
                 with_ctx_out):
    B, L, _ = x.shape
    Lc = ctx.shape[1]
    hx, gate_x = modulate(x, mod_x[:, None, :], norm_w)
    hc, gate_c = modulate(ctx, mod_c, norm_w)
    na_x, ga_x, hy_x, gh_x, re_x, gr_x = split_projection(hx @ w_in)
    na_c, ga_c, hy_c, gh_c, re_c, gr_c = split_projection(hc @ w_in)
    log_gamma = -jnp.exp(ret_log_rate.astype(F32))

    k_c, v_c = na_keys_values(na_c, k_gain)
    k_x, v_x = na_keys_values(na_x, k_gain)
    a_x = neighborhood_attention(na_queries(na_x, q_gain), k_x, v_x, k_c, v_c, rpb)
    y_x = hyena_mixer(hy_x, conv_w, conv_b,
                      hyena_filter_spectrum(L, hw1, hb1, hw2, hb2, hw3, sin_freq), skip)
    rq_c, rk_c, rv_c = retention_heads(re_c)
    s_fwd, s_bwd = context_final_states(rk_c, rv_c, log_gamma)
    rq_x, rk_x, rv_x = retention_heads(re_x)
    r_x = bidir_retention(axial_rope(rq_x), axial_rope(rk_x), rv_x, log_gamma, s_fwd, s_bwd)

    x_new = x + gate_x * merge_branches(a_x, ga_x, y_x, gh_x, r_x, gr_x, w_out)
    if not with_ctx_out:
        return x_new, None

    a_c = context_attention(na_queries(na_c, q_gain), k_c, v_c)
    y_c = hyena_mixer(hy_c, conv_w, conv_b,
                      hyena_filter_spectrum(Lc, hw1, hb1, hw2, hb2, hw3, sin_freq), skip)
    zero_state = jnp.zeros((B, RET_HEADS, RET_HEAD_DIM, RET_HEAD_DIM), F32)
    r_c = bidir_retention(rq_c, rk_c, rv_c, log_gamma, zero_state, zero_state)
    ctx_new = ctx + gate_c * merge_branches(a_c, ga_c, y_c, gh_c, r_c, gr_c, w_out)
    return x_new, ctx_new


def setup_inputs(seed: int = 0) -> dict:
    key = jax.random.key(seed)
    ks = jax.random.split(key, 24)
    nrm = lambda k, shape, s: jax.random.normal(k, shape, F32) * s
    base_rate = jnp.log(-jnp.log1p(-(2.0 ** (-5.0 - jnp.arange(RET_HEADS, dtype=F32)))))
    return {
        'x': nrm(ks[0], (BATCH, SEQ, D_MODEL), 1.0),
        'c': nrm(ks[1], (BATCH, D_MODEL), 1.0),
        'ctx': nrm(ks[2], (BATCH, CTX_LEN, D_MODEL), 1.0),
        'c_ctx': nrm(ks[3], (D_MODEL,), 1.0),
        'norm_w': 1.0 + nrm(ks[4], (DEPTH, D_MODEL), 0.02),
        'ada_w': nrm(ks[5], (DEPTH, D_MODEL, 3 * D_MODEL), 0.5 * D_MODEL ** -0.5),
        'ada_b': nrm(ks[6], (DEPTH, 3 * D_MODEL), 0.02),
        'w_in': nrm(ks[7], (DEPTH, D_MODEL, IN_W), D_MODEL ** -0.5),
        'w_out': nrm(ks[8], (DEPTH, MIX_W, D_MODEL), MIX_W ** -0.5),
        'na_q_gain': 1.0 + nrm(ks[9], (DEPTH, NA_HEAD_DIM), 0.02),
        'na_k_gain': 1.0 + nrm(ks[10], (DEPTH, NA_HEAD_DIM), 0.02),
        'na_rpb': nrm(ks[11], (DEPTH, NA_HEADS, 2 * NA_KH - 1, 2 * NA_KW - 1), 0.05),
        'hy_conv_w': nrm(ks[12], (DEPTH, HY_SHORT, 3 * HY_W), HY_SHORT ** -0.5),
        'hy_conv_b': nrm(ks[13], (DEPTH, 3 * HY_W), 0.02),
        'hy_w1': nrm(ks[14], (DEPTH, HY_EMB, HY_FFN), HY_EMB ** -0.5),
        'hy_b1': nrm(ks[15], (DEPTH, HY_FFN), 0.02),
        'hy_w2': nrm(ks[16], (DEPTH, HY_FFN, HY_FFN), HY_FFN ** -0.5),
        'hy_b2': nrm(ks[17], (DEPTH, HY_FFN), 0.02),
        'hy_w3': nrm(ks[18], (DEPTH, HY_FFN, HY_ORDER * 2 * HY_W), HY_FFN ** -0.5),
        'hy_sin_freq': 1.0 + nrm(ks[19], (DEPTH, 2, HY_FFN), 0.05),
        'hy_skip': nrm(ks[20], (DEPTH, HY_ORDER, HY_W), 1.0),
        'ret_log_rate': base_rate[None, None, :] + nrm(ks[21], (DEPTH, 2, RET_HEADS), 0.05),
    }


def reference(x, c, ctx, c_ctx, norm_w, ada_w, ada_b, w_in, w_out, na_q_gain, na_k_gain, na_rpb,
              hy_conv_w, hy_conv_b, hy_w1, hy_b1, hy_w2, hy_b2, hy_w3, hy_sin_freq, hy_skip,
              ret_log_rate):
    for i in range(DEPTH):
        mod_x = ada_modulation(c, ada_w[i], ada_b[i])
        mod_c = ada_modulation(c_ctx, ada_w[i], ada_b[i])
        x, ctx = hybrid_layer(x, ctx, mod_x, mod_c, norm_w[i], w_in[i], w_out[i],
                              na_q_gain[i], na_k_gain[i], na_rpb[i],
                              hy_conv_w[i], hy_conv_b[i], hy_w1[i], hy_b1[i], hy_w2[i], hy_b2[i],
                              hy_w3[i], hy_sin_freq[i], hy_skip[i], ret_log_rate[i],
                              i < DEPTH - 1)
    return x
```

```cpp
#include <hip/hip_runtime.h>
#include <hip/hip_cooperative_groups.h>
#include <cstdio>
#include <cstdint>
namespace cg = cooperative_groups;

#ifndef COOP
#define COOP 1
#endif

typedef unsigned short u16;
typedef short bf16x8 __attribute__((ext_vector_type(8)));
typedef float f32x4 __attribute__((ext_vector_type(4)));

constexpr int NB = 8, SEQ = 2048, LC = 256, DM = 1024, MX = 16384, MC = 2048, MALL = 18432;
constexpr int UW = 2304;
constexpr float EPS = 1e-6f;

constexpr size_t OFF_WIN = 0;
constexpr size_t OFF_WOUT = 16777216;
constexpr size_t OFF_MODS_OLD = 20971520;
constexpr size_t OFF_HZ = 21192704;
constexpr size_t OFF_U = 58941440;
constexpr size_t OFF_UT = 143876096;
constexpr size_t OFF_CTXN = 209936384;
constexpr size_t OFF_FILT = 218324992;
constexpr size_t OFF_FILTC = 235102208;
constexpr size_t OFF_RKV = 236150784;
constexpr size_t OFF_BAR = 255025152;
constexpr size_t OFF_MODS = 255025152 + 16384;
constexpr size_t ZERO_BYTES = 16384 + 221184;
constexpr size_t OFF_SHIFT = OFF_MODS + 221184;
constexpr size_t WS_END = OFF_SHIFT + 256;

struct Params {
  const float *x, *c, *ctx, *cctx, *norm_w, *ada_w, *ada_b, *w_in, *w_out, *qg, *kg, *rpb, *cw, *cb,
      *hw1, *hb1, *hw2, *hb2, *hw3, *sf, *skip, *rlr;
  float* out;
  unsigned char* ws;
};

typedef float f32x2_t __attribute__((ext_vector_type(2)));
typedef __bf16 bf16x2_t __attribute__((ext_vector_type(2)));
__device__ __forceinline__ unsigned pack2(float a, float b) {
  f32x2_t v = {a, b};
  bf16x2_t r = __builtin_convertvector(v, bf16x2_t);
  return __builtin_bit_cast(unsigned, r);
}
__device__ __forceinline__ u16 f2bf(float f) { return (u16)(pack2(f, f) & 0xffffu); }
__device__ __forceinline__ float bf2f(u16 h) { return __uint_as_float(((unsigned)h) << 16); }
__device__ __forceinline__ float lo16(unsigned v) { return __uint_as_float(v << 16); }
__device__ __forceinline__ float hi16(unsigned v) { return __uint_as_float(v & 0xffff0000u); }
__device__ __forceinline__ void sincos_rr(float a, float& sn, float& cs) {
  float k = rintf(a * 0.15915494309189535f);
  float r = fmaf(-k, 6.2831854820251465f, a);
  r = fmaf(-k, -1.7484555e-7f, r);
  sn = __sinf(r); cs = __cosf(r);
}
__device__ __forceinline__ float sin_rr(float a) { float s, c; sincos_rr(a, s, c); return s; }
__device__ __forceinline__ int tid_opaque() { int t = threadIdx.x; asm volatile("" : "+v"(t)); return t; }
__device__ __forceinline__ float silu(float v) { return v / (1.f + __expf(-v)); }
__device__ __forceinline__ int swz(int r, int kc) { return r * 64 + ((kc ^ ((r >> 1) & 7)) << 3); }
__device__ __forceinline__ bf16x8 ldfrag(const u16* p) { return *reinterpret_cast<const bf16x8*>(p); }
__device__ __forceinline__ f32x4 mfma16(bf16x8 a, bf16x8 b, f32x4 c) { return __builtin_amdgcn_mfma_f32_16x16x32_bf16(a, b, c, 0, 0, 0); }
__device__ __forceinline__ float red16_sum(float v) {
  v += __shfl_xor(v, 1); v += __shfl_xor(v, 2); v += __shfl_xor(v, 4); v += __shfl_xor(v, 8); return v;
}
__device__ __forceinline__ float red16_max(float v) {
  v = fmaxf(v, __shfl_xor(v, 1)); v = fmaxf(v, __shfl_xor(v, 2)); v = fmaxf(v, __shfl_xor(v, 4)); v = fmaxf(v, __shfl_xor(v, 8)); return v;
}

__device__ __forceinline__ void prep_transpose(const float* __restrict__ W, int N, u16* __restrict__ WT, int K, int kt, int nt, unsigned char* smem) {
  float* tile = reinterpret_cast<float*>(smem);
  const int tid = tid_opaque();
  float4 v[8];
#pragma unroll
  for (int i = 0; i < 8; ++i) {
    int r = (tid >> 5) + 8 * i, c4 = (tid & 31) * 4;
    v[i] = *reinterpret_cast<const float4*>(W + (size_t)(kt * 64 + r) * N + nt * 128 + c4);
  }
#pragma unroll
  for (int i = 0; i < 8; ++i) {
    int r = (tid >> 5) + 8 * i, c4 = (tid & 31) * 4;
    tile[r * 129 + c4 + 0] = v[i].x; tile[r * 129 + c4 + 1] = v[i].y; tile[r * 129 + c4 + 2] = v[i].z; tile[r * 129 + c4 + 3] = v[i].w;
  }
  __syncthreads();
#pragma unroll
  for (int i = 0; i < 4; ++i) {
    int n = (tid >> 3) + 32 * i, k8 = (tid & 7) * 8;
    uint4 o;
    o.x = pack2(tile[(k8 + 0) * 129 + n], tile[(k8 + 1) * 129 + n]);
    o.y = pack2(tile[(k8 + 2) * 129 + n], tile[(k8 + 3) * 129 + n]);
    o.z = pack2(tile[(k8 + 4) * 129 + n], tile[(k8 + 5) * 129 + n]);
    o.w = pack2(tile[(k8 + 6) * 129 + n], tile[(k8 + 7) * 129 + n]);
    *reinterpret_cast<uint4*>(WT + (size_t)(nt * 128 + n) * K + kt * 64 + k8) = o;
  }
  __syncthreads();
}

__device__ __forceinline__ void prep_mods(const Params& p, int layer, int cg, unsigned char* smem) {
  float* sc = reinterpret_cast<float*>(smem);
  float* red = sc + 9 * 1024;
  const int tid = tid_opaque();
  for (int i = tid; i < 9 * 1024; i += 256) {
    int r = i >> 10, k = i & 1023;
    float v = (r < 8) ? p.c[r * 1024 + k] : p.cctx[k];
    sc[i] = silu(v);
  }
  __syncthreads();
  const int col = tid & 15, ks = tid >> 4;
  const float* w = p.ada_w + (size_t)layer * 1024 * 3072 + (size_t)(ks * 64) * 3072 + cg * 16 + col;
  float acc[9];
#pragma unroll
  for (int r = 0; r < 9; ++r) acc[r] = 0.f;
#pragma unroll 1
  for (int kb = 0; kb < 64; kb += 32) {
    float wv[32];
#pragma unroll
    for (int k = 0; k < 32; ++k) wv[k] = w[(size_t)(kb + k) * 3072];
#pragma unroll
    for (int k = 0; k < 32; ++k)
#pragma unroll
      for (int r = 0; r < 9; ++r) acc[r] += sc[r * 1024 + ks * 64 + kb + k] * wv[k];
  }
#pragma unroll
  for (int r = 0; r < 9; ++r) red[(ks * 9 + r) * 16 + col] = acc[r];
  __syncthreads();
  float* mods = reinterpret_cast<float*>(p.ws + OFF_MODS);
  if (tid < 144) {
    int r = tid >> 4, cc = tid & 15;
    float sm = 0.f;
#pragma unroll
    for (int q = 0; q < 16; ++q) sm += red[(q * 9 + r) * 16 + cc];
    int n = cg * 16 + cc;
    mods[((size_t)layer * 9 + r) * 3072 + n] = sm + p.ada_b[layer * 3072 + n];
  }
  __syncthreads();
}

__device__ __forceinline__ void prep_softmax_shift(const Params& p, int layer, unsigned char* smem) {
  float* red = reinterpret_cast<float*>(smem);
  const int tid = tid_opaque();
  float mq = 0.f, mk = 0.f, mb = 0.f;
  if (tid < 64) { mq = fabsf(p.qg[layer * 64 + tid]); mk = fabsf(p.kg[layer * 64 + tid]); }
  for (int i = tid; i < 8 * 465; i += 256) mb = fmaxf(mb, fabsf(p.rpb[(size_t)layer * 8 * 465 + i]));
#pragma unroll
  for (int o = 1; o < 64; o <<= 1) { mq = fmaxf(mq, __shfl_xor(mq, o)); mk = fmaxf(mk, __shfl_xor(mk, o)); mb = fmaxf(mb, __shfl_xor(mb, o)); }
  if ((tid & 63) == 0) { red[(tid >> 6) * 3] = mq; red[(tid >> 6) * 3 + 1] = mk; red[(tid >> 6) * 3 + 2] = mb; }
  __syncthreads();
  if (tid == 0) {
    float a = fmaxf(fmaxf(red[0], red[3]), fmaxf(red[6], red[9]));
    float b = fmaxf(fmaxf(red[1], red[4]), fmaxf(red[7], red[10]));
    float c = fmaxf(fmaxf(red[2], red[5]), fmaxf(red[8], red[11]));
    float* dst = reinterpret_cast<float*>(p.ws + OFF_SHIFT);
    dst[layer * 2 + 0] = 8.0f * a * b * 1.4426950408889634f;
    dst[layer * 2 + 1] = (8.0f * a * b + c) * 1.4426950408889634f;
  }
  __syncthreads();
}

__device__ __forceinline__ void prep_filter(const Params& p, int layer, int Lx, int pb, float* __restrict__ dst, unsigned char* smem) {
  float* h1 = reinterpret_cast<float*>(smem);
  float* h2 = h1 + 1024;
  float* sw1 = h2 + 1024;
  float* sw2 = sw1 + 17 * 64;
  float* sb = sw2 + 4096;
  const int tid = tid_opaque();
  const int pp = tid >> 4, j0 = (tid & 15) * 4;
  const int pos = pb * 16 + pp;
  const float* w3 = p.hw3 + (size_t)layer * 64 * 1024;
  for (int i = tid; i < 17 * 64; i += 256) sw1[i] = p.hw1[layer * 17 * 64 + i];
  for (int i = tid; i < 4096; i += 256) sw2[i] = p.hw2[layer * 4096 + i];
  if (tid < 64) { sb[tid] = p.hb1[layer * 64 + tid]; sb[64 + tid] = p.hb2[layer * 64 + tid]; }
  if (tid < 128) sb[128 + tid] = p.sf[layer * 128 + tid];
  __syncthreads();
  {
    float z[17];
    float t = (float)pos / (float)(Lx - 1);
    float omega = 6.283185307179586f * (float)pos / (float)Lx;
    z[0] = t;
#pragma unroll
    for (int k = 0; k < 8; ++k) {
      float band = 1e-4f + (float)k * ((7.0f - 1e-4f) / 7.0f);
      float a = band * omega;
      float sn, cs; sincos_rr(a, sn, cs);
      z[1 + k] = cs;
      z[9 + k] = -sn;
    }
#pragma unroll
    for (int jj = 0; jj < 4; ++jj) {
      int j = j0 + jj;
      float sacc = sb[j];
#pragma unroll
      for (int k = 0; k < 17; ++k) sacc += z[k] * sw1[k * 64 + j];
      h1[pp * 64 + j] = sin_rr(sb[128 + j] * sacc);
    }
  }
  __syncthreads();
  {
    float sacc[4];
#pragma unroll
    for (int jj = 0; jj < 4; ++jj) sacc[jj] = sb[64 + j0 + jj];
#pragma unroll 8
    for (int k = 0; k < 64; ++k) {
      const float hv = h1[pp * 64 + k];
      const float4 wv = *reinterpret_cast<const float4*>(sw2 + k * 64 + j0);
      sacc[0] += hv * wv.x; sacc[1] += hv * wv.y; sacc[2] += hv * wv.z; sacc[3] += hv * wv.w;
    }
#pragma unroll
    for (int jj = 0; jj < 4; ++jj) h2[pp * 64 + j0 + jj] = sin_rr(sb[192 + j0 + jj] * sacc[jj]);
  }
  __syncthreads();
#pragma unroll 1
  for (int q = 0; q < 4; ++q) {
    int col = tid + 256 * q;
    float acc[16];
#pragma unroll
    for (int i = 0; i < 16; ++i) acc[i] = 0.f;
#pragma unroll 1
    for (int kb = 0; kb < 64; kb += 32) {
      float wv[32];
#pragma unroll
      for (int k = 0; k < 32; ++k) wv[k] = w3[(kb + k) * 1024 + col];
#pragma unroll
      for (int k4 = 0; k4 < 8; ++k4) {
        asm volatile("" ::: "memory");
#pragma unroll
        for (int i = 0; i < 16; ++i) {
          const float4 hv = *reinterpret_cast<const float4*>(h2 + i * 64 + kb + k4 * 4);
          acc[i] += hv.x * wv[k4 * 4] + hv.y * wv[k4 * 4 + 1] + hv.z * wv[k4 * 4 + 2] + hv.w * wv[k4 * 4 + 3];
        }
      }
    }
    int cch = col & 255;
    const float d0 = 3.0701134573253944f, d1 = 15.350567286626973f;
    float delta = d0 + (float)cch * ((d1 - d0) / 255.0f);
    float* o = dst + (size_t)col * Lx + pb * 16;
#pragma unroll
    for (int i = 0; i < 16; i += 4) {
      float4 v;
      float t0 = (float)(pb * 16 + i + 0) / (float)(Lx - 1), t1 = (float)(pb * 16 + i + 1) / (float)(Lx - 1);
      float t2 = (float)(pb * 16 + i + 2) / (float)(Lx - 1), t3 = (float)(pb * 16 + i + 3) / (float)(Lx - 1);
      v.x = acc[i + 0] * __expf(-t0 * delta); v.y = acc[i + 1] * __expf(-t1 * delta);
      v.z = acc[i + 2] * __expf(-t2 * delta); v.w = acc[i + 3] * __expf(-t3 * delta);
      *reinterpret_cast<float4*>(o + i) = v;
    }
  }
  __syncthreads();
}

__device__ __forceinline__ void prep_item(const Params& p, int it, unsigned char* smem) {
  if (it < 1024) {
    int layer = it >> 9, r = it & 511, kt = r >> 5, nt = r & 31;
    prep_transpose(p.w_in + (size_t)layer * 1024 * 4096, 4096, reinterpret_cast<u16*>(p.ws + OFF_WIN) + (size_t)layer * 4096 * 1024, 1024, kt, nt, smem);
  } else if (it < 1280) {
    int r = it - 1024; int layer = r >> 7; r &= 127; int kt = r >> 3, nt = r & 7;
    prep_transpose(p.w_out + (size_t)layer * 1024 * 1024, 1024, reinterpret_cast<u16*>(p.ws + OFF_WOUT) + (size_t)layer * 1024 * 1024, 1024, kt, nt, smem);
  } else if (it < 1664) {
    int r = it - 1280; prep_mods(p, r / 192, r % 192, smem);
  } else {
    int r = it - 1664;
    if (r < 256) prep_filter(p, r >> 7, SEQ, r & 127, reinterpret_cast<float*>(p.ws + OFF_FILT) + (size_t)(r >> 7) * 1024 * SEQ, smem);
    else prep_filter(p, 0, LC, r - 256, reinterpret_cast<float*>(p.ws + OFF_FILTC), smem);
  }
}

__device__ __forceinline__ void modulate_rows(const Params& p, int layer, int it) {
  const int tid = tid_opaque(), lane = tid & 63, w = __builtin_amdgcn_readfirstlane(tid >> 6);
  const float* nw = p.norm_w + layer * DM;
  const float* src[2]; const float* mods[2]; u16* dst[2];
  float4 v[2][4];
#pragma unroll
  for (int rr = 0; rr < 2; ++rr) {
    const int row = it * 8 + w * 2 + rr;
    int bidx;
    if (row < MX) { src[rr] = (layer == 0 ? p.x : p.out) + (size_t)row * DM; bidx = row >> 11; }
    else { src[rr] = (layer == 0 ? p.ctx : reinterpret_cast<const float*>(p.ws + OFF_CTXN)) + (size_t)(row - MX) * DM; bidx = 8; }
    mods[rr] = reinterpret_cast<const float*>(p.ws + OFF_MODS) + ((size_t)layer * 9 + bidx) * 3072;
    dst[rr] = reinterpret_cast<u16*>(p.ws + OFF_HZ) + (size_t)row * DM;
#pragma unroll
    for (int i = 0; i < 4; ++i) v[rr][i] = *reinterpret_cast<const float4*>(src[rr] + (i >> 1) * 512 + lane * 8 + (i & 1) * 4);
  }
#pragma unroll
  for (int rr = 0; rr < 2; ++rr) {
    float ss = 0.f;
#pragma unroll
    for (int i = 0; i < 4; ++i) ss += v[rr][i].x * v[rr][i].x + v[rr][i].y * v[rr][i].y + v[rr][i].z * v[rr][i].z + v[rr][i].w * v[rr][i].w;
#pragma unroll
    for (int o = 1; o < 64; o <<= 1) ss += __shfl_xor(ss, o);
    const float rstd = rsqrtf(ss * (1.0f / 1024.0f) + EPS);
    uint2 oo[4];
#pragma unroll
    for (int i = 0; i < 4; ++i) {
      const int k = (i >> 1) * 512 + lane * 8 + (i & 1) * 4;
      const float4 g = *reinterpret_cast<const float4*>(nw + k);
      const float4 sc = *reinterpret_cast<const float4*>(mods[rr] + 1024 + k);
      const float4 sh = *reinterpret_cast<const float4*>(mods[rr] + k);
      const float a0 = v[rr][i].x * rstd * g.x * (1.f + sc.x) + sh.x;
      const float a1 = v[rr][i].y * rstd * g.y * (1.f + sc.y) + sh.y;
      const float a2 = v[rr][i].z * rstd * g.z * (1.f + sc.z) + sh.z;
      const float a3 = v[rr][i].w * rstd * g.w * (1.f + sc.w) + sh.w;
      oo[i].x = pack2(a0, a1); oo[i].y = pack2(a2, a3);
    }
#pragma unroll
    for (int a = 0; a < 2; ++a) {
      uint4 o4; o4.x = oo[2 * a].x; o4.y = oo[2 * a].y; o4.z = oo[2 * a + 1].x; o4.w = oo[2 * a + 1].y;
      *reinterpret_cast<uint4*>(dst[rr] + a * 512 + lane * 8) = o4;
    }
  }
}

__device__ __forceinline__ int swz4(int r, int c) { return r * 32 + ((c ^ ((0x78 >> (((r >> 2) & 3) * 2)) & 3)) << 3); }

template <int MT, bool SWAP>
__device__ __forceinline__ void gemm_tile(const u16* __restrict__ A, const u16* __restrict__ Bt, int K, int m0, int n0,
                                          u16* lds, f32x4 (&acc)[MT][4]) {
  constexpr int BMR = 2 * MT * 16;
  constexpr int STAGE = (BMR + 128) * 32;
  constexpr int NA = BMR / 64;
  constexpr bool REM = (BMR % 64) != 0;
  const int tid = tid_opaque(), lane = tid & 63, w = __builtin_amdgcn_readfirstlane(tid >> 6), wm = w >> 1, wn = w & 1, fr = lane & 15, fq = lane >> 4;
  const int lr = tid >> 2, lc = tid & 3;
  const u16* Ap = A + (size_t)(m0 + lr) * K + lc * 8;
  const u16* Bp = Bt + (size_t)(n0 + lr) * K + lc * 8;
  uint4 ra0, ra1, ra2, ra3, rax = uint4{0u, 0u, 0u, 0u}, rb0, rb1;
  static_assert(NA == 4, "A panel is loaded as 4 rounds of 64 rows (+32)");
#define G_LOAD(KO) do { \
    ra0 = *reinterpret_cast<const uint4*>(Ap + (KO)); \
    ra1 = *reinterpret_cast<const uint4*>(Ap + (size_t)64 * K + (KO)); \
    ra2 = *reinterpret_cast<const uint4*>(Ap + (size_t)128 * K + (KO)); \
    ra3 = *reinterpret_cast<const uint4*>(Ap + (size_t)192 * K + (KO)); \
    if (REM && w < 2) rax = *reinterpret_cast<const uint4*>(Ap + (size_t)256 * K + (KO)); \
    rb0 = *reinterpret_cast<const uint4*>(Bp + (KO)); \
    rb1 = *reinterpret_cast<const uint4*>(Bp + (size_t)64 * K + (KO)); } while (0)
#define G_STORE(DST) do { u16* d_ = (DST); \
    *reinterpret_cast<uint4*>(d_ + woff) = ra0; \
    *reinterpret_cast<uint4*>(d_ + woff + 64 * 32) = ra1; \
    *reinterpret_cast<uint4*>(d_ + woff + 128 * 32) = ra2; \
    *reinterpret_cast<uint4*>(d_ + woff + 192 * 32) = ra3; \
    if (REM && w < 2) *reinterpret_cast<uint4*>(d_ + woff + 256 * 32) = rax; \
    *reinterpret_cast<uint4*>(d_ + BMR * 32 + woff) = rb0; \
    *reinterpret_cast<uint4*>(d_ + BMR * 32 + woff + 64 * 32) = rb1; } while (0)
  const int woff = swz4(lr, lc);
  G_LOAD(0);
#pragma unroll
  for (int mi = 0; mi < MT; ++mi)
#pragma unroll
    for (int ni = 0; ni < 4; ++ni) acc[mi][ni] = f32x4{0.f, 0.f, 0.f, 0.f};
  G_STORE(lds);
  __syncthreads();
  const int aoff = swz4(wm * MT * 16 + fr, fq);
  const int boff = BMR * 32 + swz4(wn * 64 + fr, fq);
  const int nk = K >> 5;
#pragma unroll 1
  for (int kt = 0; kt < nk; ++kt) {
    const u16* cur = lds + (kt & 1) * STAGE;
    const bool more = (kt + 1) < nk;
    if (more) G_LOAD((kt + 1) * 32);
    bf16x8 bfr[4], af[MT];
#pragma unroll
    for (int ni = 0; ni < 4; ++ni) bfr[ni] = ldfrag(cur + boff + ni * 16 * 32);
#pragma unroll
    for (int mi = 0; mi < MT; ++mi) af[mi] = ldfrag(cur + aoff + mi * 16 * 32);
#pragma unroll
    for (int mi = 0; mi < MT; ++mi)
#pragma unroll
      for (int ni = 0; ni < 4; ++ni) acc[mi][ni] = SWAP ? mfma16(bfr[ni], af[mi], acc[mi][ni]) : mfma16(af[mi], bfr[ni], acc[mi][ni]);
    __builtin_amdgcn_sched_group_barrier(0x100, 7, 0);
#pragma unroll
    for (int i = 0; i < MT - 3; ++i) { __builtin_amdgcn_sched_group_barrier(0x008, 4, 0); __builtin_amdgcn_sched_group_barrier(0x100, 1, 0); }
    __builtin_amdgcn_sched_group_barrier(0x008, 12, 0);
    __builtin_amdgcn_sched_barrier(0);
    if (more) G_STORE(lds + ((kt + 1) & 1) * STAGE);
    __syncthreads();
  }
#undef G_LOAD
#undef G_STORE
}

__device__ __forceinline__ void inproj_tile(const Params& p, int layer, int tile, unsigned char* smem) {
  constexpr int MT = 9;
  const int xcd_ = tile & 7, slot_ = (tile >> 3) & 63, rnd_ = tile >> 9;
  const int pm = xcd_ * 8 + (slot_ >> 3), pn = (slot_ & 7) + 8 * rnd_;
  const int m0 = pm * 288, n0 = pn * 128;
  const u16* A = reinterpret_cast<const u16*>(p.ws + OFF_HZ);
  const u16* Bt = reinterpret_cast<const u16*>(p.ws + OFF_WIN) + (size_t)layer * 4096 * 1024;
  bool tr; int dc;
  if (n0 < 1024) { tr = false; dc = n0; }
  else if (n0 < 1536) { tr = true; dc = n0 - 1024; }
  else if (n0 < 2048) { tr = false; dc = n0 - 512; }
  else if (n0 < 3072) { tr = true; dc = n0 - 2048 + 512; }
  else if (n0 < 3584) { tr = false; dc = n0 - 3072 + 1536; }
  else if (n0 < 3840) { tr = true; dc = n0 - 3584 + 1536; }
  else { tr = false; dc = n0 - 3840 + 2048; }
  f32x4 acc[MT][4];
  if (tr) {
    gemm_tile<MT, false>(A, Bt, 1024, m0, n0, reinterpret_cast<u16*>(smem), acc);
    const int tid = tid_opaque(), lane = tid & 63, w = __builtin_amdgcn_readfirstlane(tid >> 6), wm = w >> 1, wn = w & 1, fr = lane & 15, fq = lane >> 4;
    u16* UT = reinterpret_cast<u16*>(p.ws + OFF_UT);
    typedef unsigned u2_t __attribute__((ext_vector_type(2)));
    const int roff = (fq & 1) ? (16 + (fq - 1) * 4) : (fq * 4);
#pragma unroll
    for (int ni = 0; ni < 4; ++ni) {
      u16* pc = UT + (size_t)(dc + wn * 64 + ni * 16 + fr) * MALL + (m0 + wm * (MT * 16));
#pragma unroll
      for (int a = 0; a < MT / 2; ++a) {
        const unsigned ax = pack2(acc[2 * a][ni][0], acc[2 * a][ni][1]), ay = pack2(acc[2 * a][ni][2], acc[2 * a][ni][3]);
        const unsigned bx = pack2(acc[2 * a + 1][ni][0], acc[2 * a + 1][ni][1]), by = pack2(acc[2 * a + 1][ni][2], acc[2 * a + 1][ni][3]);
        const u2_t sx = __builtin_amdgcn_permlane16_swap(ax, bx, false, false);
        const u2_t sy = __builtin_amdgcn_permlane16_swap(ay, by, false, false);
        uint4 o; o.x = sx.x; o.y = sy.x; o.z = sx.y; o.w = sy.y;
        *reinterpret_cast<uint4*>(pc + a * 32 + roff) = o;
      }
      if (MT & 1) {
        uint2 o; o.x = pack2(acc[MT - 1][ni][0], acc[MT - 1][ni][1]); o.y = pack2(acc[MT - 1][ni][2], acc[MT - 1][ni][3]);
        *reinterpret_cast<uint2*>(pc + (MT - 1) * 16 + fq * 4) = o;
      }
    }
  } else {
    gemm_tile<MT, true>(A, Bt, 1024, m0, n0, reinterpret_cast<u16*>(smem), acc);
    const int tid = tid_opaque(), lane = tid & 63, w = __builtin_amdgcn_readfirstlane(tid >> 6), wm = w >> 1, wn = w & 1, fr = lane & 15, fq = lane >> 4;
    u16* U = reinterpret_cast<u16*>(p.ws + OFF_U);
    typedef unsigned u2_t __attribute__((ext_vector_type(2)));
    const int coff = (fq & 1) ? (16 + (fq - 1) * 4) : (fq * 4);
#pragma unroll
    for (int mi = 0; mi < MT; ++mi) {
      const int row = m0 + wm * (MT * 16) + mi * 16 + fr;
#pragma unroll
      for (int a = 0; a < 2; ++a) {
        const unsigned ax = pack2(acc[mi][2 * a][0], acc[mi][2 * a][1]), ay = pack2(acc[mi][2 * a][2], acc[mi][2 * a][3]);
        const unsigned bx = pack2(acc[mi][2 * a + 1][0], acc[mi][2 * a + 1][1]), by = pack2(acc[mi][2 * a + 1][2], acc[mi][2 * a + 1][3]);
        const u2_t sx = __builtin_amdgcn_permlane16_swap(ax, bx, false, false);
        const u2_t sy = __builtin_amdgcn_permlane16_swap(ay, by, false, false);
        uint4 o; o.x = sx.x; o.y = sy.x; o.z = sx.y; o.w = sy.y;
        *reinterpret_cast<uint4*>(U + (size_t)row * UW + dc + wn * 64 + a * 32 + coff) = o;
      }
    }
  }
}

template <int MT>
__device__ __forceinline__ void outproj_tile(const Params& p, int layer, int tile, unsigned char* smem) {
  const int xcd = tile & 7, slot = tile >> 3;
  const int pm = xcd * 8 + (slot >> 3), pn = slot & 7;
  const int m0 = pm * (MT * 32), n0 = pn * 128;
  f32x4 acc[MT][4];
  gemm_tile<MT, true>(reinterpret_cast<const u16*>(p.ws + OFF_HZ), reinterpret_cast<const u16*>(p.ws + OFF_WOUT) + (size_t)layer * 1024 * 1024, 1024, m0, n0,
                      reinterpret_cast<u16*>(smem), acc);
  const int tid = tid_opaque(), lane = tid & 63, w = __builtin_amdgcn_readfirstlane(tid >> 6), wm = w >> 1, wn = w & 1, fr = lane & 15, fq = lane >> 4;
  const float* mods = reinterpret_cast<const float*>(p.ws + OFF_MODS) + (size_t)layer * 9 * 3072 + 2048;
  const float* xsrc = (layer == 0) ? p.x : p.out;
  float* ctxn = reinterpret_cast<float*>(p.ws + OFF_CTXN);
#pragma unroll
  for (int mi = 0; mi < MT; ++mi) {
    const int row = m0 + wm * (MT * 16) + mi * 16 + fr;
    const bool isx = row < MX;
    const int bidx = isx ? (row >> 11) : 8;
    const float* src = isx ? (xsrc + (size_t)row * DM) : (p.ctx + (size_t)(row - MX) * DM);
    float* dst = isx ? (p.out + (size_t)row * DM) : (ctxn + (size_t)(row - MX) * DM);
    const float* gate = mods + bidx * 3072;
#pragma unroll
    for (int ni = 0; ni < 4; ++ni) {
      const int col = n0 + wn * 64 + ni * 16 + fq * 4;
      const float4 g = *reinterpret_cast<const float4*>(gate + col);
      const float4 xv = *reinterpret_cast<const float4*>(src + col);
      float4 ov;
      ov.x = xv.x + g.x * acc[mi][ni][0]; ov.y = xv.y + g.y * acc[mi][ni][1];
      ov.z = xv.z + g.z * acc[mi][ni][2]; ov.w = xv.w + g.w * acc[mi][ni][3];
      *reinterpret_cast<float4*>(dst + col) = ov;
    }
  }
}

__device__ __forceinline__ void load_qk_norm(const u16* __restrict__ U, int row0, int colbase, const float* __restrict__ gain, float mul, u16* dstlds) {
  const int tid = tid_opaque(), lr = tid >> 3, lc = tid & 7;
  float g[8];
#pragma unroll
  for (int i = 0; i < 8; ++i) g[i] = gain[lc * 8 + i] * mul;
#pragma unroll
  for (int i = 0; i < 2; ++i) {
    int r = lr + 32 * i;
    uint4 v = *reinterpret_cast<const uint4*>(U + (size_t)(row0 + r) * UW + colbase + lc * 8);
    float f[8];
    f[0] = lo16(v.x); f[1] = hi16(v.x); f[2] = lo16(v.y); f[3] = hi16(v.y);
    f[4] = lo16(v.z); f[5] = hi16(v.z); f[6] = lo16(v.w); f[7] = hi16(v.w);
    float ss = 0.f;
#pragma unroll
    for (int k = 0; k < 8; ++k) ss += f[k] * f[k];
    ss += __shfl_xor(ss, 1); ss += __shfl_xor(ss, 2); ss += __shfl_xor(ss, 4);
    float rstd = rsqrtf(ss * (1.0f / 64.0f) + EPS);
    uint4 o;
    o.x = pack2(f[0] * rstd * g[0], f[1] * rstd * g[1]);
    o.y = pack2(f[2] * rstd * g[2], f[3] * rstd * g[3]);
    o.z = pack2(f[4] * rstd * g[4], f[5] * rstd * g[5]);
    o.w = pack2(f[6] * rstd * g[6], f[7] * rstd * g[7]);
    *reinterpret_cast<uint4*>(dstlds + swz(r, lc)) = o;
  }
}

__device__ __forceinline__ void att_store_k(const uint4& v, u16* dst, const float* kg) {
  float f0 = lo16(v.x), f1 = hi16(v.x), f2 = lo16(v.y), f3 = hi16(v.y), f4 = lo16(v.z), f5 = hi16(v.z), f6 = lo16(v.w), f7 = hi16(v.w);
  float ss = f0 * f0 + f1 * f1 + f2 * f2 + f3 * f3 + f4 * f4 + f5 * f5 + f6 * f6 + f7 * f7;
  ss += __shfl_xor(ss, 1); ss += __shfl_xor(ss, 2); ss += __shfl_xor(ss, 4);
  float rstd = rsqrtf(ss * (1.0f / 64.0f) + EPS);
  float4 g0 = *reinterpret_cast<const float4*>(kg), g1 = *reinterpret_cast<const float4*>(kg + 4);
  uint4 ov;
  ov.x = pack2(f0 * rstd * g0.x, f1 * rstd * g0.y);
  ov.y = pack2(f2 * rstd * g0.z, f3 * rstd * g0.w);
  ov.z = pack2(f4 * rstd * g1.x, f5 * rstd * g1.y);
  ov.w = pack2(f6 * rstd * g1.z, f7 * rstd * g1.w);
  *reinterpret_cast<uint4*>(dst) = ov;
}

template <bool LOCAL>
__device__ __forceinline__ void attn_mtile2(const u16* sQw, const u16* sK, const u16* sVT, const float* sBias, const int mi0,
                                            const int fr, const int fq, const int dr, const float negC, f32x4 (&o)[4][4], float (&l)[4]) {
  constexpr int NKT = LOCAL ? 2 : 4;
  int nb[2];
#pragma unroll
  for (int t = 0; t < 2; ++t) { const int mi = mi0 + t; nb[t] = LOCAL ? ((mi == 0) ? 0 : (mi == 1) ? 8 : (mi == 2) ? 24 : 32) : 0; }
  bf16x8 qf[2][2], kf[2][NKT][2];
#pragma unroll
  for (int t = 0; t < 2; ++t) {
    qf[t][0] = ldfrag(sQw + swz((mi0 + t) * 16 + fr, fq));
    qf[t][1] = ldfrag(sQw + swz((mi0 + t) * 16 + fr, 4 + fq));
  }
#pragma unroll
  for (int t = 0; t < (LOCAL ? 2 : 1); ++t)
#pragma unroll
    for (int kt = 0; kt < NKT; ++kt) {
      kf[t][kt][0] = ldfrag(sK + swz(nb[t] + kt * 16 + fr, fq));
      kf[t][kt][1] = ldfrag(sK + swz(nb[t] + kt * 16 + fr, 4 + fq));
    }
  float bv[2][8];
  if (LOCAL) {
#pragma unroll
    for (int t = 0; t < 2; ++t) {
      const float* bl = sBias + dr * 31 + (fq * 4 - fr) + (15 + nb[t] - (mi0 + t) * 16);
#pragma unroll
      for (int kt = 0; kt < 2; ++kt)
#pragma unroll
        for (int j = 0; j < 4; ++j) bv[t][kt * 4 + j] = bl[kt * 16 + j];
    }
  }
  __builtin_amdgcn_sched_barrier(0);
  f32x4 st[2][NKT];
#pragma unroll
  for (int t = 0; t < 2; ++t)
#pragma unroll
    for (int kt = 0; kt < NKT; ++kt) {
      const int tk = LOCAL ? t : 0;
      const float ini = LOCAL ? 0.f : negC;
      st[t][kt] = mfma16(kf[tk][kt][0], qf[t][0], f32x4{ini, ini, ini, ini});
      st[t][kt] = mfma16(kf[tk][kt][1], qf[t][1], st[t][kt]);
    }
  uint2 vlo[2][NKT / 2][4], vhi[2][NKT / 2][4];
#pragma unroll
  for (int t = 0; t < (LOCAL ? 2 : 1); ++t)
#pragma unroll
    for (int a = 0; a < NKT / 2; ++a)
#pragma unroll
      for (int dt = 0; dt < 4; ++dt) {
        const int c0 = (nb[t] >> 3) + 4 * a + (fq >> 1);
        vlo[t][a][dt] = *reinterpret_cast<const uint2*>(sVT + swz(dt * 16 + fr, c0) + (fq & 1) * 4);
        vhi[t][a][dt] = *reinterpret_cast<const uint2*>(sVT + swz(dt * 16 + fr, c0 + 2) + (fq & 1) * 4);
      }
  if (LOCAL) {
#pragma unroll
    for (int t = 0; t < 2; ++t) {
      const int cq = (mi0 + t) * 16 + fr;
      const int cs = min(max(cq - 8, 0), 48);
      const int tt = nb[t] + fq * 4 - cs;
#pragma unroll
      for (int kt = 0; kt < 2; ++kt)
#pragma unroll
        for (int j = 0; j < 4; ++j) {
          const bool ok = (unsigned)(tt + kt * 16 + j) < 16u;
          st[t][kt][j] = ok ? (st[t][kt][j] + bv[t][kt * 4 + j]) : -1e30f;
        }
    }
  }
#pragma unroll
  for (int t = 0; t < 2; ++t) {
    float ps = 0.f;
#pragma unroll
    for (int kt = 0; kt < NKT; ++kt)
#pragma unroll
      for (int j = 0; j < 4; ++j) { const float pv = __builtin_amdgcn_exp2f(st[t][kt][j]); st[t][kt][j] = pv; ps += pv; }
    l[mi0 + t] += ps;
  }
#pragma unroll
  for (int t = 0; t < 2; ++t)
#pragma unroll
    for (int a = 0; a < NKT / 2; ++a) {
      uint4 pk;
      pk.x = pack2(st[t][2 * a][0], st[t][2 * a][1]); pk.y = pack2(st[t][2 * a][2], st[t][2 * a][3]);
      pk.z = pack2(st[t][2 * a + 1][0], st[t][2 * a + 1][1]); pk.w = pack2(st[t][2 * a + 1][2], st[t][2 * a + 1][3]);
      const bf16x8 pf = *reinterpret_cast<bf16x8*>(&pk);
      const int tv = LOCAL ? t : 0;
#pragma unroll
      for (int dt = 0; dt < 4; ++dt) {
        uint4 vv; vv.x = vlo[tv][a][dt].x; vv.y = vlo[tv][a][dt].y; vv.z = vhi[tv][a][dt].x; vv.w = vhi[tv][a][dt].y;
        o[mi0 + t][dt] = mfma16(*reinterpret_cast<bf16x8*>(&vv), pf, o[mi0 + t][dt]);
      }
    }
  __builtin_amdgcn_sched_barrier(0);
}

__device__ __forceinline__ void attn_item(const Params& p, int layer, int item, unsigned char* smem) {
  u16* sKV = reinterpret_cast<u16*>(smem);
  u16* sP = sKV + 16384;
  float* sBias = reinterpret_cast<float*>(smem + 40960);
  float* sKg = sBias + 468;
  u16* sQ = reinterpret_cast<u16*>(smem + 43520);
  const int tid = tid_opaque(), lane = tid & 63, w = __builtin_amdgcn_readfirstlane(tid >> 6), fr = lane & 15, fq = lane >> 4;
  const u16* U = reinterpret_cast<const u16*>(p.ws + OFF_U);
  const u16* UT = reinterpret_cast<const u16*>(p.ws + OFF_UT);
  const bool lat = item < 512;
  int b, h, qrow0, r = 0, R0 = 0, kr_lo = 0, nlocal = 0;
  if (lat) {
    b = item >> 6; h = (item >> 3) & 7; const int g = item & 7;
    r = g * 4 + w; R0 = min(max(r - 4, 0), 24);
    kr_lo = min(max(g * 4 - 4, 0), 24);
    const int kr_hi = min(max(g * 4 + 3 - 4, 0), 24) + 7;
    nlocal = kr_hi - kr_lo + 1;
    qrow0 = b * SEQ + g * 256;
  } else {
    const int it = item - 512; b = it >> 3; h = it & 7; qrow0 = MX + b * LC;
  }
  const float negC = -reinterpret_cast<const float*>(p.ws + OFF_SHIFT)[layer * 2 + (lat ? 1 : 0)];
  if (lat) {
    const float* rp = p.rpb + ((size_t)layer * 8 + h) * 465;
    for (int i = tid; i < 465; i += 256) sBias[i] = rp[i] * 1.4426950408889634f + negC;
  }
  if (tid < 64) sKg[tid] = p.kg[layer * 64 + tid];
#pragma unroll 1
  for (int qq = 0; qq < 4; ++qq) load_qk_norm(U, qrow0 + qq * 64, h * 64, p.qg + layer * 64, 0.125f * 1.4426950408889634f, sQ + qq * 4096);
  __syncthreads();
  f32x4 o[4][4];
  float l[4];
#pragma unroll
  for (int mi = 0; mi < 4; ++mi) {
    l[mi] = 0.f;
#pragma unroll
    for (int j = 0; j < 4; ++j) o[mi][j] = f32x4{0.f, 0.f, 0.f, 0.f};
  }
  u16* sPw = sP + w * 1024;
  const int nch = nlocal + 4;
  const int lr = tid >> 3, lc = tid & 7;
  const int vd = tid >> 2, vpart = tid & 3;
  uint4 rk0, rk1, rv0, rv1;
#define ATT_ISSUE(CH) do { const int ch_ = (CH); \
    const int krow0_ = (ch_ < nlocal) ? (b * SEQ + (kr_lo + ch_) * 64) : (MX + b * LC + (ch_ - nlocal) * 64); \
    rk0 = *reinterpret_cast<const uint4*>(U + (size_t)(krow0_ + lr) * UW + 512 + h * 64 + lc * 8); \
    rk1 = *reinterpret_cast<const uint4*>(U + (size_t)(krow0_ + lr + 32) * UW + 512 + h * 64 + lc * 8); \
    rv0 = *reinterpret_cast<const uint4*>(UT + (size_t)(h * 64 + vd) * MALL + krow0_ + (vpart * 2) * 8); \
    rv1 = *reinterpret_cast<const uint4*>(UT + (size_t)(h * 64 + vd) * MALL + krow0_ + (vpart * 2 + 1) * 8); } while (0)
#define ATT_STORE(BUF) do { u16* dK_ = sKV + (BUF) * 4096; u16* dV_ = sKV + 8192 + (BUF) * 4096; \
    att_store_k(rk0, dK_ + swz(lr, lc), sKg + lc * 8); att_store_k(rk1, dK_ + swz(lr + 32, lc), sKg + lc * 8); \
    *reinterpret_cast<uint4*>(dV_ + swz(vd, vpart * 2)) = rv0; *reinterpret_cast<uint4*>(dV_ + swz(vd, vpart * 2 + 1)) = rv1; } while (0)
  ATT_ISSUE(0);
  ATT_STORE(0);
  __syncthreads();
#pragma unroll 1
  for (int ch = 0; ch < nch; ++ch) {
    const bool more = (ch + 1) < nch;
    if (more) ATT_ISSUE(ch + 1);
    __builtin_amdgcn_sched_barrier(0);
    const bool local = ch < nlocal;
    const int kr = kr_lo + ch;
    const bool active = !local || (kr >= R0 && kr <= R0 + 7);
    const u16* sK = sKV + (ch & 1) * 4096;
    const u16* sVT = sKV + 8192 + (ch & 1) * 4096;
    if (active) {
      int frl = fr, fql = fq;
      asm volatile("" : "+v"(frl), "+v"(fql));
      if (local) {
        const int dr = kr - r + 7;
        attn_mtile2<true>(sQ + w * 4096, sK, sVT, sBias, 0, frl, fql, dr, negC, o, l);
        attn_mtile2<true>(sQ + w * 4096, sK, sVT, sBias, 2, frl, fql, dr, negC, o, l);
      } else {
        attn_mtile2<false>(sQ + w * 4096, sK, sVT, sBias, 0, frl, fql, 0, negC, o, l);
        attn_mtile2<false>(sQ + w * 4096, sK, sVT, sBias, 2, frl, fql, 0, negC, o, l);
      }
    }
    __builtin_amdgcn_sched_barrier(0);
    if (more) ATT_STORE((ch + 1) & 1);
    __syncthreads();
  }
  u16* Z = reinterpret_cast<u16*>(p.ws + OFF_HZ);
#pragma unroll
  for (int mi = 0; mi < 4; ++mi) {
    int fre = fr, fqe = fq;
    asm volatile("" : "+v"(fre), "+v"(fqe) :: "memory");
    float lt = l[mi];
    lt += __shfl_xor(lt, 16);
    lt += __shfl_xor(lt, 32);
    const float inv = 1.0f / lt;
    const int row = qrow0 + w * 64 + mi * 16 + fre;
    typedef unsigned u2a_t __attribute__((ext_vector_type(2)));
    const int coff = (fqe & 1) ? (16 + (fqe - 1) * 4) : (fqe * 4);
    uint2 ovv[4];
#pragma unroll
    for (int dt = 0; dt < 4; ++dt) {
      const int dcol = h * 64 + dt * 16 + fqe * 4;
      uint2 gv = *reinterpret_cast<const uint2*>(U + (size_t)row * UW + 1024 + dcol);
      ovv[dt].x = pack2(o[mi][dt][0] * inv * silu(lo16(gv.x)), o[mi][dt][1] * inv * silu(hi16(gv.x)));
      ovv[dt].y = pack2(o[mi][dt][2] * inv * silu(lo16(gv.y)), o[mi][dt][3] * inv * silu(hi16(gv.y)));
    }
#pragma unroll
    for (int a = 0; a < 2; ++a) {
      const u2a_t sx = __builtin_amdgcn_permlane16_swap(ovv[2 * a].x, ovv[2 * a + 1].x, false, false);
      const u2a_t sy = __builtin_amdgcn_permlane16_swap(ovv[2 * a].y, ovv[2 * a + 1].y, false, false);
      uint4 o4; o4.x = sx.x; o4.y = sy.x; o4.z = sx.y; o4.w = sy.y;
      *reinterpret_cast<uint4*>(Z + (size_t)row * DM + h * 64 + a * 32 + coff) = o4;
    }
  }
  asm volatile("" ::: "memory");
  __syncthreads();
}

template <typename F>
__device__ __forceinline__ void ret_load_rope(const u16* __restrict__ U, int rowbase, int colbase, bool rope, int tpos0, float mul, F&& sink) {
  const int tid = tid_opaque();
#pragma unroll
  for (int i = 0; i < 2; ++i) {
    int id = tid + 256 * i;
    int l = id >> 2, pr = id & 3;
    int c = (pr & 1) + ((pr >> 1) << 2);
    const u16* src = U + (size_t)(rowbase + l) * UW + colbase + c * 8;
    uint4 v1 = *reinterpret_cast<const uint4*>(src);
    uint4 v2 = *reinterpret_cast<const uint4*>(src + 16);
    float x1[8], x2[8];
    x1[0] = lo16(v1.x); x1[1] = hi16(v1.x); x1[2] = lo16(v1.y); x1[3] = hi16(v1.y);
    x1[4] = lo16(v1.z); x1[5] = hi16(v1.z); x1[6] = lo16(v1.w); x1[7] = hi16(v1.w);
    x2[0] = lo16(v2.x); x2[1] = hi16(v2.x); x2[2] = lo16(v2.y); x2[3] = hi16(v2.y);
    x2[4] = lo16(v2.z); x2[5] = hi16(v2.z); x2[6] = lo16(v2.w); x2[7] = hi16(v2.w);
    float o1[8], o2[8];
    if (rope) {
      int t = tpos0 + l;
      float pos = (float)((c >= 4) ? (t & 63) : (t >> 6));
#pragma unroll
      for (int k = 0; k < 8; ++k) {
        int fi = (c & 1) * 8 + k;
        float freq = exp2f(-(float)fi * (13.287712379549449f / 16.0f));
        float ang = pos * freq;
        float sn, cs; sincos_rr(ang, sn, cs);
        o1[k] = (x1[k] * cs - x2[k] * sn) * mul;
        o2[k] = (x1[k] * sn + x2[k] * cs) * mul;
      }
    } else {
#pragma unroll
      for (int k = 0; k < 8; ++k) { o1[k] = x1[k] * mul; o2[k] = x2[k] * mul; }
    }
    sink(l, c, o1, o2);
  }
}

__device__ __forceinline__ void ret_load_vt(const u16* __restrict__ UT, int h, int rowbase, u16* sVT) {
  const int tid = tid_opaque();
  int e = tid >> 2, part = tid & 3;
#pragma unroll
  for (int i = 0; i < 4; ++i) {
    int kg = part * 4 + i;
    uint4 v = *reinterpret_cast<const uint4*>(UT + (size_t)(1536 + h * 64 + e) * MALL + rowbase + kg * 8);
    *reinterpret_cast<uint4*>(sVT + (kg >> 3) * 4096 + swz(e, kg & 7)) = v;
  }
}

__device__ __forceinline__ void retkv_item(const Params& p, int layer, int item, unsigned char* smem) {
  u16* sVT = reinterpret_cast<u16*>(smem);
  u16* sKf = sVT + 8192;
  u16* sKb = sVT + 16384;
  const int tid = tid_opaque(), lane = tid & 63, w = __builtin_amdgcn_readfirstlane(tid >> 6), fr = lane & 15, fq = lane >> 4;
  const int ci = item % 18, bh = item / 18, h = bh & 3, b = bh >> 2;
  const bool lat = ci < 16;
  const int rowbase = lat ? (b * SEQ + ci * 128) : (MX + b * LC + (ci - 16) * 128);
  const float lgf = -__expf(p.rlr[layer * 8 + h]), lgb = -__expf(p.rlr[layer * 8 + 4 + h]);
  const u16* U = reinterpret_cast<const u16*>(p.ws + OFF_U);
  const u16* UT = reinterpret_cast<const u16*>(p.ws + OFF_UT);
  ret_load_vt(UT, h, rowbase, sVT);
  ret_load_rope(U, rowbase, 1792 + h * 64, lat, ci * 128, 0.125f, [&](int l, int c, float* o1, float* o2) {
    float wf = __expf(lgf * (float)(127 - l)), wb = __expf(lgb * (float)l);
    int pan = (l >> 6) * 4096, kc = (l & 63) >> 3, e7 = l & 7;
#pragma unroll
    for (int k = 0; k < 8; ++k) {
      int d1 = c * 8 + k, d2 = d1 + 16;
      sKf[pan + swz(d1, kc) + e7] = f2bf(o1[k] * wf);
      sKf[pan + swz(d2, kc) + e7] = f2bf(o2[k] * wf);
      sKb[pan + swz(d1, kc) + e7] = f2bf(o1[k] * wb);
      sKb[pan + swz(d2, kc) + e7] = f2bf(o2[k] * wb);
    }
  });
  __syncthreads();
  f32x4 acc[2][4];
#pragma unroll
  for (int d = 0; d < 2; ++d)
#pragma unroll
    for (int ni = 0; ni < 4; ++ni) acc[d][ni] = f32x4{0.f, 0.f, 0.f, 0.f};
#pragma unroll
  for (int ks = 0; ks < 4; ++ks) {
    int pan = (ks >> 1) * 4096, kc = (ks & 1) * 4 + fq;
    bf16x8 a = ldfrag(sVT + pan + swz(w * 16 + fr, kc));
#pragma unroll
    for (int ni = 0; ni < 4; ++ni) {
      bf16x8 bf_ = ldfrag(sKf + pan + swz(ni * 16 + fr, kc));
      bf16x8 bb_ = ldfrag(sKb + pan + swz(ni * 16 + fr, kc));
      acc[0][ni] = mfma16(bf_, a, acc[0][ni]);
      acc[1][ni] = mfma16(bb_, a, acc[1][ni]);
    }
  }
  float* dst = reinterpret_cast<float*>(p.ws + OFF_RKV) + (size_t)item * 2 * 4096;
#pragma unroll
  for (int d = 0; d < 2; ++d)
#pragma unroll
    for (int ni = 0; ni < 4; ++ni)
      *reinterpret_cast<float4*>(dst + d * 4096 + (w * 16 + fr) * 64 + ni * 16 + fq * 4) = float4{acc[d][ni][0], acc[d][ni][1], acc[d][ni][2], acc[d][ni][3]};
  __syncthreads();
}

__device__ __forceinline__ void retout_item(const Params& p, int layer, int item, unsigned char* smem) {
  u16* sQ = reinterpret_cast<u16*>(smem);
  u16* sK = sQ + 8192;
  u16* sVT = sQ + 16384;
  u16* sPf = sQ + 24576;
  u16* sPb = sQ + 28672;
  u16* sP = sQ;
  const int tid = tid_opaque(), lane = tid & 63, w = __builtin_amdgcn_readfirstlane(tid >> 6), fr = lane & 15, fq = lane >> 4;
  const int ci = item % 18, bh = item / 18, h = bh & 3, b = bh >> 2;
  const bool lat = ci < 16;
  const int rowbase = lat ? (b * SEQ + ci * 128) : (MX + b * LC + (ci - 16) * 128);
  const float lgf = -__expf(p.rlr[layer * 8 + h]), lgb = -__expf(p.rlr[layer * 8 + 4 + h]);
  const u16* U = reinterpret_cast<const u16*>(p.ws + OFF_U);
  const u16* UT = reinterpret_cast<const u16*>(p.ws + OFF_UT);
  ret_load_vt(UT, h, rowbase, sVT);
  ret_load_rope(U, rowbase, 1536 + h * 64, lat, ci * 128, 1.0f, [&](int l, int c, float* o1, float* o2) {
    uint4 a, bq;
    a.x = pack2(o1[0], o1[1]); a.y = pack2(o1[2], o1[3]); a.z = pack2(o1[4], o1[5]); a.w = pack2(o1[6], o1[7]);
    bq.x = pack2(o2[0], o2[1]); bq.y = pack2(o2[2], o2[3]); bq.z = pack2(o2[4], o2[5]); bq.w = pack2(o2[6], o2[7]);
    *reinterpret_cast<uint4*>(sQ + swz(l, c)) = a;
    *reinterpret_cast<uint4*>(sQ + swz(l, c + 2)) = bq;
  });
  ret_load_rope(U, rowbase, 1792 + h * 64, lat, ci * 128, 0.125f, [&](int l, int c, float* o1, float* o2) {
    uint4 a, bq;
    a.x = pack2(o1[0], o1[1]); a.y = pack2(o1[2], o1[3]); a.z = pack2(o1[4], o1[5]); a.w = pack2(o1[6], o1[7]);
    bq.x = pack2(o2[0], o2[1]); bq.y = pack2(o2[2], o2[3]); bq.z = pack2(o2[4], o2[5]); bq.w = pack2(o2[6], o2[7]);
    *reinterpret_cast<uint4*>(sK + swz(l, c)) = a;
    *reinterpret_cast<uint4*>(sK + swz(l, c + 2)) = bq;
  });
  {
    const float* kvb = reinterpret_cast<const float*>(p.ws + OFF_RKV) + (size_t)bh * 18 * 2 * 4096;
    const int e = tid >> 2, d0 = (tid & 3) * 16;
    float af[16], ab[16];
#pragma unroll
    for (int i = 0; i < 16; ++i) { af[i] = 0.f; ab[i] = 0.f; }
    const int nsrc = lat ? 19 : 1;
#pragma unroll 1
    for (int kb = 0; kb < nsrc; kb += 4) {
      float4 v[4][4];
      float wgt[4];
      int dirs[4];
#pragma unroll
      for (int u = 0; u < 4; ++u) {
        const int k = kb + u;
        int m = 0, dir = 0; float wv = 0.f;
        if (lat) {
          if (k < ci) { m = k; dir = 0; wv = __expf(lgf * 128.f * (float)(ci - 1 - k)); }
          else if (k == ci) { m = 16; dir = 0; wv = __expf(lgf * 128.f * (float)(ci + 1)); }
          else if (k == ci + 1) { m = 17; dir = 0; wv = __expf(lgf * 128.f * (float)ci); }
          else if (k < 19) {
            const int q = k - (ci + 2);
            dir = 1;
            if (q < 15 - ci) { m = ci + 1 + q; wv = __expf(lgb * 128.f * (float)q); }
            else if (q == 15 - ci) { m = 16; wv = __expf(lgb * 128.f * (float)(15 - ci)); }
            else { m = 17; wv = __expf(lgb * 128.f * (float)(16 - ci)); }
          }
        } else if (k == 0) {
          if (ci == 16) { m = 17; dir = 1; wv = 1.f; } else { m = 16; dir = 0; wv = 1.f; }
        }
        wgt[u] = wv; dirs[u] = dir;
        const float* sp = kvb + ((size_t)m * 2 + dir) * 4096 + e * 64 + d0;
#pragma unroll
        for (int i = 0; i < 4; ++i) v[u][i] = *reinterpret_cast<const float4*>(sp + i * 4);
      }
      __builtin_amdgcn_sched_barrier(0);
#pragma unroll
      for (int u = 0; u < 4; ++u) {
        const float wf = dirs[u] == 0 ? wgt[u] : 0.f, wb = dirs[u] == 0 ? 0.f : wgt[u];
#pragma unroll
        for (int i = 0; i < 4; ++i) {
          af[i * 4 + 0] += wf * v[u][i].x; af[i * 4 + 1] += wf * v[u][i].y; af[i * 4 + 2] += wf * v[u][i].z; af[i * 4 + 3] += wf * v[u][i].w;
          ab[i * 4 + 0] += wb * v[u][i].x; ab[i * 4 + 1] += wb * v[u][i].y; ab[i * 4 + 2] += wb * v[u][i].z; ab[i * 4 + 3] += wb * v[u][i].w;
        }
      }
    }
#pragma unroll
    for (int hf = 0; hf < 2; ++hf) {
      uint4 a, bq;
      a.x = pack2(af[hf * 8 + 0], af[hf * 8 + 1]); a.y = pack2(af[hf * 8 + 2], af[hf * 8 + 3]); a.z = pack2(af[hf * 8 + 4], af[hf * 8 + 5]); a.w = pack2(af[hf * 8 + 6], af[hf * 8 + 7]);
      bq.x = pack2(ab[hf * 8 + 0], ab[hf * 8 + 1]); bq.y = pack2(ab[hf * 8 + 2], ab[hf * 8 + 3]); bq.z = pack2(ab[hf * 8 + 4], ab[hf * 8 + 5]); bq.w = pack2(ab[hf * 8 + 6], ab[hf * 8 + 7]);
      *reinterpret_cast<uint4*>(sPf + swz(e, (d0 >> 3) + hf)) = a;
      *reinterpret_cast<uint4*>(sPb + swz(e, (d0 >> 3) + hf)) = bq;
    }
  }
  __syncthreads();
  f32x4 S[2][8], Of[2][4], Ob[2][4];
#pragma unroll
  for (int mi = 0; mi < 2; ++mi) {
#pragma unroll
    for (int ni = 0; ni < 8; ++ni) S[mi][ni] = f32x4{0.f, 0.f, 0.f, 0.f};
#pragma unroll
    for (int ni = 0; ni < 4; ++ni) { Of[mi][ni] = f32x4{0.f, 0.f, 0.f, 0.f}; Ob[mi][ni] = f32x4{0.f, 0.f, 0.f, 0.f}; }
  }
#pragma unroll
  for (int ks = 0; ks < 2; ++ks) {
    bf16x8 qa[2];
#pragma unroll
    for (int mi = 0; mi < 2; ++mi) qa[mi] = ldfrag(sQ + swz(w * 32 + mi * 16 + fr, ks * 4 + fq));
#pragma unroll
    for (int ni = 0; ni < 8; ++ni) {
      bf16x8 kf = ldfrag(sK + swz(ni * 16 + fr, ks * 4 + fq));
#pragma unroll
      for (int mi = 0; mi < 2; ++mi) S[mi][ni] = mfma16(qa[mi], kf, S[mi][ni]);
    }
#pragma unroll
    for (int ni = 0; ni < 4; ++ni) {
      bf16x8 pf = ldfrag(sPf + swz(ni * 16 + fr, ks * 4 + fq));
      bf16x8 pb = ldfrag(sPb + swz(ni * 16 + fr, ks * 4 + fq));
#pragma unroll
      for (int mi = 0; mi < 2; ++mi) { Of[mi][ni] = mfma16(qa[mi], pf, Of[mi][ni]); Ob[mi][ni] = mfma16(qa[mi], pb, Ob[mi][ni]); }
    }
  }
  __syncthreads();
#pragma unroll
  for (int mi = 0; mi < 2; ++mi)
#pragma unroll
    for (int ni = 0; ni < 8; ++ni) {
      int lcol = ni * 16 + fr;
#pragma unroll
      for (int j = 0; j < 4; ++j) {
        int jrow = w * 32 + mi * 16 + fq * 4 + j;
        int diff = jrow - lcol;
        float dd = 0.f;
        if (diff >= 0) dd += __expf(lgf * (float)diff);
        if (diff <= 0) dd += __expf(lgb * (float)(-diff));
        sP[(lcol >> 6) * 8192 + swz(jrow, (lcol & 63) >> 3) + (lcol & 7)] = f2bf(S[mi][ni][j] * dd);
      }
    }
  __syncthreads();
  f32x4 O[2][4];
#pragma unroll
  for (int mi = 0; mi < 2; ++mi)
#pragma unroll
    for (int ni = 0; ni < 4; ++ni) O[mi][ni] = f32x4{0.f, 0.f, 0.f, 0.f};
#pragma unroll
  for (int ks = 0; ks < 4; ++ks) {
    int kc = (ks & 1) * 4 + fq;
    bf16x8 pa[2];
#pragma unroll
    for (int mi = 0; mi < 2; ++mi) pa[mi] = ldfrag(sP + (ks >> 1) * 8192 + swz(w * 32 + mi * 16 + fr, kc));
#pragma unroll
    for (int ni = 0; ni < 4; ++ni) {
      bf16x8 vf = ldfrag(sVT + (ks >> 1) * 4096 + swz(ni * 16 + fr, kc));
#pragma unroll
      for (int mi = 0; mi < 2; ++mi) O[mi][ni] = mfma16(pa[mi], vf, O[mi][ni]);
    }
  }
  u16* Z = reinterpret_cast<u16*>(p.ws + OFF_HZ);
#pragma unroll
  for (int mi = 0; mi < 2; ++mi)
#pragma unroll
    for (int j = 0; j < 4; ++j) {
      int jrow = w * 32 + mi * 16 + fq * 4 + j;
      float xf = __expf(lgf * (float)(jrow + 1)), xb = __expf(lgb * (float)(128 - jrow));
      float v[4], ss = 0.f;
#pragma unroll
      for (int ni = 0; ni < 4; ++ni) { v[ni] = O[mi][ni][j] + xf * Of[mi][ni][j] + xb * Ob[mi][ni][j]; ss += v[ni] * v[ni]; }
      ss = red16_sum(ss);
      float rstd = rsqrtf(ss * (1.0f / 64.0f) + EPS);
      int row = rowbase + jrow;
#pragma unroll
      for (int ni = 0; ni < 4; ++ni) {
        int e = ni * 16 + fr;
        float g = bf2f(U[(size_t)row * UW + 2048 + h * 64 + e]);
        Z[(size_t)row * DM + 768 + h * 64 + e] = f2bf(v[ni] * rstd * silu(g));
      }
    }
  __syncthreads();
}

__device__ __forceinline__ float block_sum(float v, float* red) {
#pragma unroll
  for (int o = 1; o < 64; o <<= 1) v += __shfl_xor(v, o);
  __syncthreads();
  if ((threadIdx.x & 63) == 0) red[threadIdx.x >> 6] = v;
  __syncthreads();
  return red[0] + red[1] + red[2] + red[3];
}

struct HyRaw { uint4 v; u16 e0, e1; };
template <int LX>
__device__ __forceinline__ HyRaw hy_load8(const u16* __restrict__ s, int tc) {
  HyRaw r;
  r.v = *reinterpret_cast<const uint4*>(s);
  r.e0 = (tc > 0) ? s[-1] : (u16)0;
  r.e1 = (tc < LX / 8 - 1) ? s[8] : (u16)0;
  return r;
}
__device__ __forceinline__ void hy_eval8(const HyRaw& r, float w0, float w1, float w2, float bb, float* o) {
  float f[10];
  f[0] = bf2f(r.e0);
  f[1] = lo16(r.v.x); f[2] = hi16(r.v.x); f[3] = lo16(r.v.y); f[4] = hi16(r.v.y);
  f[5] = lo16(r.v.z); f[6] = hi16(r.v.z); f[7] = lo16(r.v.w); f[8] = hi16(r.v.w);
  f[9] = bf2f(r.e1);
#pragma unroll
  for (int i = 0; i < 8; ++i) o[i] = w0 * f[i] + w1 * f[i + 1] + w2 * f[i + 2] + bb;
}

template <int LX, int NT>
__device__ __forceinline__ void hyena_item(const Params& p, int layer, int c, unsigned char* smem) {
  constexpr int T1 = LX / 32;
  constexpr int RSTR = 2 * LX + 32;
  u16* sU = reinterpret_cast<u16*>(smem);
  u16* sR = sU + 16384 + 256;
  float* red = reinterpret_cast<float*>(smem + 32768 + 512 + 4 * (2 * SEQ + 32) * 2);
  const int tid = tid_opaque(), lane = tid & 63, w = __builtin_amdgcn_readfirstlane(tid >> 6), fr = lane & 15, fq = lane >> 4;
  const int rowbase = (LX == SEQ) ? 0 : MX;
  const u16* UT = reinterpret_cast<const u16*>(p.ws + OFF_UT);
  const float* filt = (LX == SEQ) ? (reinterpret_cast<const float*>(p.ws + OFF_FILT) + (size_t)layer * 1024 * SEQ) : reinterpret_cast<const float*>(p.ws + OFF_FILTC);
  const float* cw = p.cw + layer * 3 * 768;
  const float* cb = p.cb + layer * 768;
  u16* Z = reinterpret_cast<u16*>(p.ws + OFF_HZ);
  constexpr int NTAP = (2 * LX - 1 + 255) / 256;
  float taps[NTAP];
  {
    const float* ff = filt + (size_t)(0 * 256 + c) * LX;
    const float* fb = filt + (size_t)(1 * 256 + c) * LX;
#pragma unroll
    for (int i = 0; i < NTAP; ++i) {
      const int y = tid + 256 * i;
      taps[i] = (y < LX) ? ff[LX - 1 - y] : ((y < 2 * LX - 1) ? fb[y - (LX - 1)] : 0.f);
    }
  }
  if (tid < 32) { unsigned zz; asm volatile("v_mov_b32 %0, 0" : "=v"(zz)); *reinterpret_cast<uint4*>(sU + (T1 * 4 * 8) * 8 + tid * 8) = uint4{zz, zz, zz, zz}; }
  {
    const float w0 = cw[c], w1 = cw[768 + c], w2 = cw[1536 + c], bb = cb[c];
    const u16* src = UT + (size_t)(512 + c) * MALL + rowbase;
    constexpr int NIT = LX / 256;
    constexpr int NBT = (NIT < 4) ? NIT : 4;
#pragma unroll 1
    for (int it0 = 0; it0 < NIT; it0 += NBT) {
      HyRaw raw[NBT];
#pragma unroll
      for (int it = 0; it < NBT; ++it) { const int id = tid + 256 * (it0 + it); const int b = id / (LX / 8), tc = id % (LX / 8); raw[it] = hy_load8<LX>(src + b * LX + tc * 8, tc); }
      __builtin_amdgcn_sched_barrier(0);
#pragma unroll
      for (int it = 0; it < NBT; ++it) {
        const int id = tid + 256 * (it0 + it); const int b = id / (LX / 8), tc = id % (LX / 8);
        float o[8];
        hy_eval8(raw[it], w0, w1, w2, bb, o);
        uint4 ov; ov.x = pack2(o[0], o[1]); ov.y = pack2(o[2], o[3]); ov.z = pack2(o[4], o[5]); ov.w = pack2(o[6], o[7]);
        *reinterpret_cast<uint4*>(sU + (tc * 8 + b) * 8) = ov;
      }
    }
  }
  const int t1lo = w * NT * 2;
#pragma unroll 1
  for (int ord = 0; ord < 2; ++ord) {
    {
      float sa = 0.f;
#pragma unroll
      for (int i = 0; i < NTAP; ++i) sa += fabsf(taps[i]);
      float tot = block_sum(sa, red);
      float inv = 1.0f / tot;
#pragma unroll
      for (int i = 0; i < NTAP; ++i) {
        const int y = tid + 256 * i;
        if (y < 2 * LX - 1) {
          u16 hv = f2bf(taps[i] * inv);
          sR[y] = hv;
          if (y >= 1) sR[RSTR + y - 1] = hv;
          if (y >= 2) sR[2 * RSTR + y - 2] = hv;
          if (y >= 3) sR[3 * RSTR + y - 3] = hv;
        }
      }
    }
    __syncthreads();
    if (ord == 0) {
      const float* ff = filt + (size_t)(2 * 256 + c) * LX;
      const float* fb = filt + (size_t)(3 * 256 + c) * LX;
#pragma unroll
      for (int i = 0; i < NTAP; ++i) {
        const int y = tid + 256 * i;
        taps[i] = (y < LX) ? ff[LX - 1 - y] : ((y < 2 * LX - 1) ? fb[y - (LX - 1)] : 0.f);
      }
    }
    f32x4 acc[2][NT];
#pragma unroll
    for (int mi = 0; mi < 2; ++mi)
#pragma unroll
      for (int ni = 0; ni < NT; ++ni) acc[mi][ni] = f32x4{0.f, 0.f, 0.f, 0.f};
    const int d1lo = t1lo - (T1 - 1), d1hi = t1lo + NT * 2 - 1;
    bf16x8 a0[2], b0[NT], a1[2], b1[NT];
    int ubase[NT];
#pragma unroll
    for (int ni = 0; ni < NT; ++ni) ubase[ni] = (w * NT + ni) * 16 + fr;
#define HY_LOAD(D1, AF, BF) do { const int d1_ = (D1); \
      _Pragma("unroll") for (int mi = 0; mi < 2; ++mi) { \
        int y0 = (LX - 1) - (32 * d1_ + mi * 16 + fr - fq * 8); int sh = y0 & 3; \
        const u16* q = sR + sh * RSTR + (y0 - sh); \
        uint2 lo = *reinterpret_cast<const uint2*>(q); uint2 hi = *reinterpret_cast<const uint2*>(q + 4); \
        uint4 pk; pk.x = lo.x; pk.y = lo.y; pk.z = hi.x; pk.w = hi.y; AF[mi] = *reinterpret_cast<bf16x8*>(&pk); } \
      _Pragma("unroll") for (int ni = 0; ni < NT; ++ni) { \
        int t1s = (ubase[ni] >> 3) - d1_; \
        t1s = ((unsigned)t1s < (unsigned)T1) ? t1s : T1; \
        BF[ni] = ldfrag(sU + ((4 * t1s + fq) * 8 + (ubase[ni] & 7)) * 8); } } while (0)
#define HY_MMA(AF, BF) do { \
      _Pragma("unroll") for (int ni = 0; ni < NT; ++ni) \
        _Pragma("unroll") for (int mi = 0; mi < 2; ++mi) acc[mi][ni] = mfma16(AF[mi], BF[ni], acc[mi][ni]); } while (0)
    HY_LOAD(d1lo, a0, b0);
#pragma unroll 1
    for (int d1 = d1lo; d1 <= d1hi; d1 += 2) {
      HY_LOAD(min(d1 + 1, d1hi), a1, b1);
      HY_MMA(a0, b0);
      HY_LOAD(min(d1 + 2, d1hi), a0, b0);
      if (d1 + 1 <= d1hi) HY_MMA(a1, b1);
    }
#undef HY_MMA
#undef HY_LOAD
    __syncthreads();
    {
      int fr_e = fr, fq_e = fq;
      asm volatile("" : "+v"(fr_e), "+v"(fq_e));
      const float skipv = p.skip[(layer * 2 + ord) * 256 + c];
#pragma unroll
      for (int ni = 0; ni < NT; ++ni) {
        int n = (w * NT + ni) * 16 + fr_e;
        int t1 = n >> 3, b = n & 7;
#pragma unroll
        for (int mi = 0; mi < 2; ++mi) {
          int t = 32 * t1 + mi * 16 + fq_e * 4;
          u16* up = sU + (((t >> 3) * 8 + b) * 8 + (t & 7));
          uint2 uv = *reinterpret_cast<const uint2*>(up);
          uint2 ov;
          ov.x = pack2(acc[mi][ni][0] + lo16(uv.x) * skipv, acc[mi][ni][1] + hi16(uv.x) * skipv);
          ov.y = pack2(acc[mi][ni][2] + lo16(uv.y) * skipv, acc[mi][ni][3] + hi16(uv.y) * skipv);
          *reinterpret_cast<uint2*>(up) = ov;
        }
      }
    }
    __syncthreads();
    {
      const int gch = (ord == 0) ? (768 + c) : (1024 + c);
      const int cwi = (ord == 0) ? (256 + c) : (512 + c);
      const float w0 = cw[cwi], w1 = cw[768 + cwi], w2 = cw[1536 + cwi], bb = cb[cwi];
      const u16* src = UT + (size_t)gch * MALL + rowbase;
      const u16* ghs = UT + (size_t)(1280 + c) * MALL + rowbase;
      constexpr int NIT = LX / 256;
      constexpr int NBT = (NIT < 4) ? NIT : 4;
#pragma unroll 1
      for (int it0 = 0; it0 < NIT; it0 += NBT) {
        HyRaw raw[NBT];
        uint4 ghv[NBT];
#pragma unroll
        for (int it = 0; it < NBT; ++it) {
          const int id = tid + 256 * (it0 + it); const int b = id / (LX / 8), tc = id % (LX / 8);
          raw[it] = hy_load8<LX>(src + b * LX + tc * 8, tc);
          ghv[it] = (ord == 1) ? *reinterpret_cast<const uint4*>(ghs + b * LX + tc * 8) : uint4{0u, 0u, 0u, 0u};
        }
        __builtin_amdgcn_sched_barrier(0);
#pragma unroll
        for (int it = 0; it < NBT; ++it) {
          const int id = tid + 256 * (it0 + it); const int b = id / (LX / 8), tc = id % (LX / 8);
          float g[8];
          hy_eval8(raw[it], w0, w1, w2, bb, g);
          u16* up = sU + (tc * 8 + b) * 8;
          uint4 uv = *reinterpret_cast<const uint4*>(up);
          float y[8] = {lo16(uv.x), hi16(uv.x), lo16(uv.y), hi16(uv.y), lo16(uv.z), hi16(uv.z), lo16(uv.w), hi16(uv.w)};
          if (ord == 0) {
            uint4 ov;
            ov.x = pack2(y[0] * g[0], y[1] * g[1]); ov.y = pack2(y[2] * g[2], y[3] * g[3]);
            ov.z = pack2(y[4] * g[4], y[5] * g[5]); ov.w = pack2(y[6] * g[6], y[7] * g[7]);
            *reinterpret_cast<uint4*>(up) = ov;
          } else {
            const uint4 hv = ghv[it];
            float hg[8] = {lo16(hv.x), hi16(hv.x), lo16(hv.y), hi16(hv.y), lo16(hv.z), hi16(hv.z), lo16(hv.w), hi16(hv.w)};
            u16* zp = Z + (size_t)(rowbase + b * LX + tc * 8) * DM + 512 + c;
#pragma unroll
            for (int j = 0; j < 8; ++j) zp[(size_t)j * DM] = f2bf(y[j] * g[j] * silu(hg[j]));
          }
        }
      }
    }
    __syncthreads();
  }
}

__device__ __forceinline__ void run_phase(const Params& p, int ph, unsigned char* smem, int only);
constexpr int LDS_BYTES = 77824;
__device__ __forceinline__ void run_phase(const Params& p, int ph, unsigned char* smem, int only) {
  const int nb = gridDim.x, bid = blockIdx.x;
#ifndef MIX_REP
#define MIX_REP 0
#endif
#ifndef PH_MASK
#define PH_MASK 0xff
#endif
  if (ph == 0) {
    if (PH_MASK & 1) for (int it = bid; it < 1938; it += nb) { if (it < 2) prep_softmax_shift(p, it, smem); else prep_item(p, 1937 - it, smem); }
    return;
  }
  const int layer = (ph - 1) / 5, sub = (ph - 1) % 5;
  if (sub == 0) {
    if (PH_MASK & 2) {
      if (nb == 512) {
        const int x = bid & 7, sl = bid >> 3;
        for (int k = sl; k < 288; k += 64) modulate_rows(p, layer, x * 288 + k);
      } else {
        for (int it = bid; it < MALL / 8; it += nb) modulate_rows(p, layer, it);
      }
    }
  } else if (sub == 1) {
    if (PH_MASK & 4) for (int it = bid; it < 64 * 32; it += nb) inproj_tile(p, layer, it, smem);
  } else if (sub == 2) {
    if (PH_MASK & 8) for (int it = bid; it < 576; it += nb) retkv_item(p, layer, it, smem);
  } else if (sub == 3) {
    const int half = nb >> 1;
    for (int step = 0;; ++step) {
      int kind = -1, idx = 0;
      if (bid < half) {
        const int i = bid + (step >> 1) * half;
        if (i >= 256) break;
        if (step & 1) { kind = 1; idx = 256 + i; } else { kind = 0; idx = ((i & 7) << 5) | (i >> 3); }
      } else {
        const int q = step / 6, sub = step - q * 6;
        const int j = (bid - half) + q * half;
        if (j >= 256) break;
        if (sub == 0) { kind = 1; idx = j; }
        else if (sub == 1) { if (layer == 0 && (j < 64 || j >= 128)) { kind = 2; idx = j; } }
        else if (sub == 2 || sub == 3) { const int r2 = 2 * j + (sub - 2); kind = 3; idx = (r2 >> 4) * 18 + (r2 & 15); }
        else if (sub == 4) { if (layer == 0 && j < 64) { kind = 1; idx = 512 + j; } else if (layer == 0 && j >= 128 && j < 192) { kind = 2; idx = j - 64; } }
        else { if (layer == 0 && j >= 64 && j < 128) { kind = 3; idx = ((j - 64) >> 1) * 18 + 16 + ((j - 64) & 1); } }
      }
      if (kind < 0) continue;
      if (only >= 0 && only != kind) continue;
      if (kind == 0) { if (PH_MASK & 16) hyena_item<SEQ, 8>(p, layer, idx, smem); }
      else if (kind == 1) { if (PH_MASK & 64) attn_item(p, layer, idx, smem); }
      else if (kind == 2) { if (PH_MASK & 16) hyena_item<LC, 1>(p, layer, idx, smem); }
      else { if (PH_MASK & 32) retout_item(p, layer, idx, smem); }
    }
  } else {
    if (PH_MASK & 128) {
      if (layer == 0) { for (int it = bid; it < 512; it += nb) outproj_tile<9>(p, layer, it, smem); }
      else { for (int it = bid; it < 512; it += nb) outproj_tile<8>(p, layer, it, smem); }
    }
  }
}

#define XB_TMO      128
#define XB_XCNT(j)  (256  + 64 * (j))
#define XB_XSUB(j)  (1280 + 64 * (j))
#define XB_XGEN(j)  (2304 + 64 * (j))
#define XB_TOP      3328
#define XB_TOPGEN   3392
#define XCD_BAR_WORDS 3456
#define XB_SPIN_CAP (1u << 22)
__device__ __forceinline__ unsigned xb_ld(unsigned* p)              { return __hip_atomic_load(p, __ATOMIC_RELAXED, __HIP_MEMORY_SCOPE_AGENT); }
__device__ __forceinline__ unsigned xb_add(unsigned* p, unsigned v) { return __hip_atomic_fetch_add(p, v, __ATOMIC_RELAXED, __HIP_MEMORY_SCOPE_AGENT); }
__device__ __forceinline__ unsigned xb_xcc_id() { return (unsigned)__builtin_amdgcn_s_getreg((3 << 11) | 20) & 0xFu; }
#define XB_SPIN(cond, bar) do { unsigned _sp = 0; while (cond) { __builtin_amdgcn_s_sleep(1); \
    if ((++_sp & 255u) == 0u) { if (xb_ld(&(bar)[XB_TMO])) break; if (_sp > XB_SPIN_CAP) { atomicAdd(&(bar)[XB_TMO], 1u); break; } } } } while (0)
struct XcdBarrier { unsigned* bar; unsigned x; volatile unsigned* st; };
__device__ __forceinline__ void xcd_barrier_complete(unsigned* bar, unsigned x, unsigned& nloc, unsigned& nx) {
  const unsigned G = gridDim.x * gridDim.y * gridDim.z;
  unsigned sum, cnt, mine, sp = 0u;
  for (;;) {
    sum = 0u; cnt = 0u; mine = 0u;
#pragma unroll
    for (unsigned j = 0; j < 16; ++j) { const unsigned c = xb_ld(&bar[XB_XCNT(j)]); sum += c; cnt += (c > 0u) ? 1u : 0u; mine = (j == x) ? c : mine; }
    if (sum == G) break;
    __builtin_amdgcn_s_sleep(1);
    if ((++sp & 255u) == 0u) { if (xb_ld(&bar[XB_TMO])) break; if (sp > XB_SPIN_CAP) { atomicAdd(&bar[XB_TMO], 1u); break; } }
  }
  nloc = mine > 0u ? mine : 1u; nx = cnt > 0u ? cnt : 1u;
}
__device__ __forceinline__ void xcd_barrier(XcdBarrier& b) {
  asm volatile("s_waitcnt vmcnt(0)" ::: "memory");
  __syncthreads();
  if (threadIdx.x == 0) {
    unsigned* bar = b.bar;
    __builtin_amdgcn_s_waitcnt(0);
    unsigned nloc = b.st[0], nx = b.st[1];
    if (nloc == 0u) { xcd_barrier_complete(bar, b.x, nloc, nx); b.st[0] = nloc; b.st[1] = nx; }
    const unsigned old = xb_add(&bar[XB_XSUB(b.x)], 1u);
    const unsigned gen = old / nloc;
    if (old + 1u == (gen + 1u) * nloc) {
      __builtin_amdgcn_fence(__ATOMIC_RELEASE, "agent");
      asm volatile("s_waitcnt vmcnt(0)" ::: "memory");
      const unsigned og = xb_add(&bar[XB_TOP], 1u);
      const unsigned tg = og / nx;
      if (og + 1u == (tg + 1u) * nx) xb_add(&bar[XB_TOPGEN], 1u);
      else XB_SPIN(xb_ld(&bar[XB_TOPGEN]) == tg, bar);
      __builtin_amdgcn_fence(__ATOMIC_ACQUIRE, "agent");
      xb_add(&bar[XB_XGEN(b.x)], 1u);
      asm volatile("s_waitcnt vmcnt(0)" ::: "memory");
    } else {
      XB_SPIN(xb_ld(&bar[XB_XGEN(b.x)]) == gen, bar);
      __builtin_amdgcn_fence(__ATOMIC_ACQUIRE, "agent");
      asm volatile("s_waitcnt vmcnt(0)" ::: "memory");
    }
  }
  __syncthreads();
}

constexpr int NPHASE = 11;

__global__ void __launch_bounds__(256, 2) mega_kernel(Params p, int ph_lo, int ph_hi, int use_cg) {
  extern __shared__ __attribute__((aligned(16))) unsigned char smem[];
  XcdBarrier xb;
  xb.bar = reinterpret_cast<unsigned*>(p.ws + OFF_BAR); xb.x = xb_xcc_id(); xb.st = reinterpret_cast<volatile unsigned*>(smem + LDS_BYTES - 16);
  if (threadIdx.x == 0) { xb.st[0] = 0u; xb.st[1] = 0u; }
  __syncthreads();
  if (!use_cg && ph_hi - ph_lo > 1 && threadIdx.x == 0) (void)xb_add(&xb.bar[XB_XCNT(xb.x)], 1u);
  for (int ph = ph_lo; ph < ph_hi; ++ph) {
    int nrep = 1;
#ifdef REP_MASK
    {
      int kind = (ph == 0) ? 0 : 1 + (ph - 1) % 5;
      if (((REP_MASK >> kind) & 1) && !(kind == 5 && ph > 5)) nrep = 2;
    }
#endif
#ifndef REP_ONLY
#define REP_ONLY -1
#endif
#pragma unroll 1
    for (int rep = 0; rep < nrep; ++rep) run_phase(p, ph, smem, rep == 0 ? -1 : REP_ONLY);
    if (ph + 1 < ph_hi) {
      if (use_cg) cg::this_grid().sync();
      else xcd_barrier(xb);
    }
  }
}

extern "C" void kernel_launch(void* const* d_in, const int* in_sizes, int n_in, void* d_out, int out_size, void* d_ws, size_t ws_size,
                              hipStream_t stream) {
  static int grid_blocks = 0;
  if (!grid_blocks) {
    int dev = 0, cus = 0, per_cu = 0;
    hipGetDevice(&dev);
    hipDeviceGetAttribute(&cus, hipDeviceAttributeMultiprocessorCount, dev);
    hipFuncSetAttribute((const void*)mega_kernel, hipFuncAttributeMaxDynamicSharedMemorySize, LDS_BYTES);
    hipOccupancyMaxActiveBlocksPerMultiprocessor(&per_cu, mega_kernel, 256, LDS_BYTES);
    if (per_cu < 1) per_cu = 1;
    if (per_cu > 2) per_cu = 2;
    grid_blocks = cus * per_cu;
    if (ws_size < WS_END) fprintf(stderr, "kernel_launch: workspace too small (%zu < %zu)\n", ws_size, (size_t)WS_END);
  }
  Params p{};
  const float** pp = reinterpret_cast<const float**>(&p);
  for (int i = 0; i < 22; ++i) pp[i] = (const float*)d_in[i];
  p.out = (float*)d_out;
  p.ws = (unsigned char*)d_ws;
#if COOP
  hipMemsetAsync((unsigned char*)d_ws + OFF_BAR, 0, 16384, stream);
  int lo = 0, hi = NPHASE, ucg = 0;
  void* args[] = {&p, &lo, &hi, &ucg};
  hipError_t e = hipLaunchCooperativeKernel((void*)mega_kernel, dim3(grid_blocks), dim3(256), args, LDS_BYTES, stream);
  if (e != hipSuccess) fprintf(stderr, "cooperative launch failed: %s (grid %d)\n", hipGetErrorString(e), grid_blocks);
#else
  for (int ph = 0; ph < NPHASE; ++ph) hipLaunchKernelGGL(mega_kernel, dim3(grid_blocks), dim3(256), LDS_BYTES, stream, p, ph, ph + 1, 0);
#endif
}
```

```cpp
#include <hip/hip_runtime.h>
#include <hip/hip_cooperative_groups.h>
#include <cstdio>
#include <cstdint>
namespace cg = cooperative_groups;

#ifndef COOP
#define COOP 1
#endif

typedef unsigned short u16;
typedef short bf16x8 __attribute__((ext_vector_type(8)));
typedef float f32x4 __attribute__((ext_vector_type(4)));

constexpr int NB = 8, SEQ = 2048, LC = 256, DM = 1024, MX = 16384, MC = 2048, MALL = 18432;
constexpr int UW = 2304;
constexpr float EPS = 1e-6f;

constexpr size_t OFF_WIN = 0;
constexpr size_t OFF_WOUT = 16777216;
constexpr size_t OFF_MODS_OLD = 20971520;
constexpr size_t OFF_HZ = 21192704;
constexpr size_t OFF_U = 58941440;
constexpr size_t OFF_UT = 143876096;
constexpr size_t OFF_CTXN = 209936384;
constexpr size_t OFF_FILT = 218324992;
constexpr size_t OFF_FILTC = 235102208;
constexpr size_t OFF_RKV = 236150784;
constexpr size_t OFF_BAR = 255025152;
constexpr size_t OFF_MODS = 255025152 + 16384;
constexpr size_t ZERO_BYTES = 16384 + 221184;
constexpr size_t OFF_SHIFT = OFF_MODS + 221184;
constexpr size_t WS_END = OFF_SHIFT + 256;

struct Params {
  const float *x, *c, *ctx, *cctx, *norm_w, *ada_w, *ada_b, *w_in, *w_out, *qg, *kg, *rpb, *cw, *cb,
      *hw1, *hb1, *hw2, *hb2, *hw3, *sf, *skip, *rlr;
  float* out;
  unsigned char* ws;
};

typedef float f32x2_t __attribute__((ext_vector_type(2)));
typedef __bf16 bf16x2_t __attribute__((ext_vector_type(2)));
__device__ __forceinline__ unsigned pack2(float a, float b) {
  f32x2_t v = {a, b};
  bf16x2_t r = __builtin_convertvector(v, bf16x2_t);
  return __builtin_bit_cast(unsigned, r);
}
__device__ __forceinline__ u16 f2bf(float f) { return (u16)(pack2(f, f) & 0xffffu); }
__device__ __forceinline__ float bf2f(u16 h) { return __uint_as_float(((unsigned)h) << 16); }
__device__ __forceinline__ float lo16(unsigned v) { return __uint_as_float(v << 16); }
__device__ __forceinline__ float hi16(unsigned v) { return __uint_as_float(v & 0xffff0000u); }
__device__ __forceinline__ void sincos_rr(float a, float& sn, float& cs) {
  float k = rintf(a * 0.15915494309189535f);
  float r = fmaf(-k, 6.2831854820251465f, a);
  r = fmaf(-k, -1.7484555e-7f, r);
  sn = __sinf(r); cs = __cosf(r);
}
__device__ __forceinline__ float sin_rr(float a) { float s, c; sincos_rr(a, s, c); return s; }
__device__ __forceinline__ int tid_opaque() { int t = threadIdx.x; asm volatile("" : "+v"(t)); return t; }
__device__ __forceinline__ float silu(float v) { return v / (1.f + __expf(-v)); }
__device__ __forceinline__ int swz(int r, int kc) { return r * 64 + ((kc ^ ((r >> 1) & 7)) << 3); }
__device__ __forceinline__ bf16x8 ldfrag(const u16* p) { return *reinterpret_cast<const bf16x8*>(p); }
__device__ __forceinline__ f32x4 mfma16(bf16x8 a, bf16x8 b, f32x4 c) { return __builtin_amdgcn_mfma_f32_16x16x32_bf16(a, b, c, 0, 0, 0); }
__device__ __forceinline__ float red16_sum(float v) {
  v += __shfl_xor(v, 1); v += __shfl_xor(v, 2); v += __shfl_xor(v, 4); v += __shfl_xor(v, 8); return v;
}
__device__ __forceinline__ float red16_max(float v) {
  v = fmaxf(v, __shfl_xor(v, 1)); v = fmaxf(v, __shfl_xor(v, 2)); v = fmaxf(v, __shfl_xor(v, 4)); v = fmaxf(v, __shfl_xor(v, 8)); return v;
}

__device__ __forceinline__ void prep_transpose(const float* __restrict__ W, int N, u16* __restrict__ WT, int K, int kt, int nt, unsigned char* smem) {
  float* tile = reinterpret_cast<float*>(smem);
  const int tid = tid_opaque();
  float4 v[8];
#pragma unroll
  for (int i = 0; i < 8; ++i) {
    int r = (tid >> 5) + 8 * i, c4 = (tid & 31) * 4;
    v[i] = *reinterpret_cast<const float4*>(W + (size_t)(kt * 64 + r) * N + nt * 128 + c4);
  }
#pragma unroll
  for (int i = 0; i < 8; ++i) {
    int r = (tid >> 5) + 8 * i, c4 = (tid & 31) * 4;
    tile[r * 129 + c4 + 0] = v[i].x; tile[r * 129 + c4 + 1] = v[i].y; tile[r * 129 + c4 + 2] = v[i].z; tile[r * 129 + c4 + 3] = v[i].w;
  }
  __syncthreads();
#pragma unroll
  for (int i = 0; i < 4; ++i) {
    int n = (tid >> 3) + 32 * i, k8 = (tid & 7) * 8;
    uint4 o;
    o.x = pack2(tile[(k8 + 0) * 129 + n], tile[(k8 + 1) * 129 + n]);
    o.y = pack2(tile[(k8 + 2) * 129 + n], tile[(k8 + 3) * 129 + n]);
    o.z = pack2(tile[(k8 + 4) * 129 + n], tile[(k8 + 5) * 129 + n]);
    o.w = pack2(tile[(k8 + 6) * 129 + n], tile[(k8 + 7) * 129 + n]);
    *reinterpret_cast<uint4*>(WT + (size_t)(nt * 128 + n) * K + kt * 64 + k8) = o;
  }
  __syncthreads();
}

__device__ __forceinline__ void prep_mods(const Params& p, int layer, int cg, unsigned char* smem) {
  float* sc = reinterpret_cast<float*>(smem);
  float* red = sc + 9 * 1024;
  const int tid = tid_opaque();
  for (int i = tid; i < 9 * 1024; i += 256) {
    int r = i >> 10, k = i & 1023;
    float v = (r < 8) ? p.c[r * 1024 + k] : p.cctx[k];
    sc[i] = silu(v);
  }
  __syncthreads();
  const int col = tid & 15, ks = tid >> 4;
  const float* w = p.ada_w + (size_t)layer * 1024 * 3072 + (size_t)(ks * 64) * 3072 + cg * 16 + col;
  float acc[9];
#pragma unroll
  for (int r = 0; r < 9; ++r) acc[r] = 0.f;
#pragma unroll 1
  for (int kb = 0; kb < 64; kb += 32) {
    float wv[32];
#pragma unroll
    for (int k = 0; k < 32; ++k) wv[k] = w[(size_t)(kb + k) * 3072];
#pragma unroll
    for (int k = 0; k < 32; ++k)
#pragma unroll
      for (int r = 0; r < 9; ++r) acc[r] += sc[r * 1024 + ks * 64 + kb + k] * wv[k];
  }
#pragma unroll
  for (int r = 0; r < 9; ++r) red[(ks * 9 + r) * 16 + col] = acc[r];
  __syncthreads();
  float* mods = reinterpret_cast<float*>(p.ws + OFF_MODS);
  if (tid < 144) {
    int r = tid >> 4, cc = tid & 15;
    float sm = 0.f;
#pragma unroll
    for (int q = 0; q < 16; ++q) sm += red[(q * 9 + r) * 16 + cc];
    int n = cg * 16 + cc;
    mods[((size_t)layer * 9 + r) * 3072 + n] = sm + p.ada_b[layer * 3072 + n];
  }
  __syncthreads();
}

__device__ __forceinline__ void prep_softmax_shift(const Params& p, int layer, unsigned char* smem) {
  float* red = reinterpret_cast<float*>(smem);
  const int tid = tid_opaque();
  float mq = 0.f, mk = 0.f, mb = 0.f;
  if (tid < 64) { mq = fabsf(p.qg[layer * 64 + tid]); mk = fabsf(p.kg[layer * 64 + tid]); }
  for (int i = tid; i < 8 * 465; i += 256) mb = fmaxf(mb, fabsf(p.rpb[(size_t)layer * 8 * 465 + i]));
#pragma unroll
  for (int o = 1; o < 64; o <<= 1) { mq = fmaxf(mq, __shfl_xor(mq, o)); mk = fmaxf(mk, __shfl_xor(mk, o)); mb = fmaxf(mb, __shfl_xor(mb, o)); }
  if ((tid & 63) == 0) { red[(tid >> 6) * 3] = mq; red[(tid >> 6) * 3 + 1] = mk; red[(tid >> 6) * 3 + 2] = mb; }
  __syncthreads();
  if (tid == 0) {
    float a = fmaxf(fmaxf(red[0], red[3]), fmaxf(red[6], red[9]));
    float b = fmaxf(fmaxf(red[1], red[4]), fmaxf(red[7], red[10]));
    float c = fmaxf(fmaxf(red[2], red[5]), fmaxf(red[8], red[11]));
    float* dst = reinterpret_cast<float*>(p.ws + OFF_SHIFT);
    dst[layer * 2 + 0] = 8.0f * a * b * 1.4426950408889634f;
    dst[layer * 2 + 1] = (8.0f * a * b + c) * 1.4426950408889634f;
  }
  __syncthreads();
}

__device__ __forceinline__ void prep_filter(const Params& p, int layer, int Lx, int pb, float* __restrict__ dst, unsigned char* smem) {
  float* h1 = reinterpret_cast<float*>(smem);
  float* h2 = h1 + 1024;
  float* sw1 = h2 + 1024;
  float* sw2 = sw1 + 17 * 64;
  float* sb = sw2 + 4096;
  const int tid = tid_opaque();
  const int pp = tid >> 4, j0 = (tid & 15) * 4;
  const int pos = pb * 16 + pp;
  const float* w3 = p.hw3 + (size_t)layer * 64 * 1024;
  for (int i = tid; i < 17 * 64; i += 256) sw1[i] = p.hw1[layer * 17 * 64 + i];
  for (int i = tid; i < 4096; i += 256) sw2[i] = p.hw2[layer * 4096 + i];
  if (tid < 64) { sb[tid] = p.hb1[layer * 64 + tid]; sb[64 + tid] = p.hb2[layer * 64 + tid]; }
  if (tid < 128) sb[128 + tid] = p.sf[layer * 128 + tid];
  __syncthreads();
  {
    float z[17];
    float t = (float)pos / (float)(Lx - 1);
    float omega = 6.283185307179586f * (float)pos / (float)Lx;
    z[0] = t;
#pragma unroll
    for (int k = 0; k < 8; ++k) {
      float band = 1e-4f + (float)k * ((7.0f - 1e-4f) / 7.0f);
      float a = band * omega;
      float sn, cs; sincos_rr(a, sn, cs);
      z[1 + k] = cs;
      z[9 + k] = -sn;
    }
#pragma unroll
    for (int jj = 0; jj < 4; ++jj) {
      int j = j0 + jj;
      float sacc = sb[j];
#pragma unroll
      for (int k = 0; k < 17; ++k) sacc += z[k] * sw1[k * 64 + j];
      h1[pp * 64 + j] = sin_rr(sb[128 + j] * sacc);
    }
  }
  __syncthreads();
  {
    float sacc[4];
#pragma unroll
    for (int jj = 0; jj < 4; ++jj) sacc[jj] = sb[64 + j0 + jj];
#pragma unroll 8
    for (int k = 0; k < 64; ++k) {
      const float hv = h1[pp * 64 + k];
      const float4 wv = *reinterpret_cast<const float4*>(sw2 + k * 64 + j0);
      sacc[0] += hv * wv.x; sacc[1] += hv * wv.y; sacc[2] += hv * wv.z; sacc[3] += hv * wv.w;
    }
#pragma unroll
    for (int jj = 0; jj < 4; ++jj) h2[pp * 64 + j0 + jj] = sin_rr(sb[192 + j0 + jj] * sacc[jj]);
  }
  __syncthreads();
#pragma unroll 1
  for (int q = 0; q < 4; ++q) {
    int col = tid + 256 * q;
    float acc[16];
#pragma unroll
    for (int i = 0; i < 16; ++i) acc[i] = 0.f;
#pragma unroll 1
    for (int kb = 0; kb < 64; kb += 32) {
      float wv[32];
#pragma unroll
      for (int k = 0; k < 32; ++k) wv[k] = w3[(kb + k) * 1024 + col];
#pragma unroll
      for (int k4 = 0; k4 < 8; ++k4) {
        asm volatile("" ::: "memory");
#pragma unroll
        for (int i = 0; i < 16; ++i) {
          const float4 hv = *reinterpret_cast<const float4*>(h2 + i * 64 + kb + k4 * 4);
          acc[i] += hv.x * wv[k4 * 4] + hv.y * wv[k4 * 4 + 1] + hv.z * wv[k4 * 4 + 2] + hv.w * wv[k4 * 4 + 3];
        }
      }
    }
    int cch = col & 255;
    const float d0 = 3.0701134573253944f, d1 = 15.350567286626973f;
    float delta = d0 + (float)cch * ((d1 - d0) / 255.0f);
    float* o = dst + (size_t)col * Lx + pb * 16;
#pragma unroll
    for (int i = 0; i < 16; i += 4) {
      float4 v;
      float t0 = (float)(pb * 16 + i + 0) / (float)(Lx - 1), t1 = (float)(pb * 16 + i + 1) / (float)(Lx - 1);
      float t2 = (float)(pb * 16 + i + 2) / (float)(Lx - 1), t3 = (float)(pb * 16 + i + 3) / (float)(Lx - 1);
      v.x = acc[i + 0] * __expf(-t0 * delta); v.y = acc[i + 1] * __expf(-t1 * delta);
      v.z = acc[i + 2] * __expf(-t2 * delta); v.w = acc[i + 3] * __expf(-t3 * delta);
      *reinterpret_cast<float4*>(o + i) = v;
    }
  }
  __syncthreads();
}

__device__ __forceinline__ void prep_item(const Params& p, int it, unsigned char* smem) {
  if (it < 1024) {
    int layer = it >> 9, r = it & 511, kt = r >> 5, nt = r & 31;
    prep_transpose(p.w_in + (size_t)layer * 1024 * 4096, 4096, reinterpret_cast<u16*>(p.ws + OFF_WIN) + (size_t)layer * 4096 * 1024, 1024, kt, nt, smem);
  } else if (it < 1280) {
    int r = it - 1024; int layer = r >> 7; r &= 127; int kt = r >> 3, nt = r & 7;
    prep_transpose(p.w_out + (size_t)layer * 1024 * 1024, 1024, reinterpret_cast<u16*>(p.ws + OFF_WOUT) + (size_t)layer * 1024 * 1024, 1024, kt, nt, smem);
  } else if (it < 1664) {
    int r = it - 1280; prep_mods(p, r / 192, r % 192, smem);
  } else {
    int r = it - 1664;
    if (r < 256) prep_filter(p, r >> 7, SEQ, r & 127, reinterpret_cast<float*>(p.ws + OFF_FILT) + (size_t)(r >> 7) * 1024 * SEQ, smem);
    else prep_filter(p, 0, LC, r - 256, reinterpret_cast<float*>(p.ws + OFF_FILTC), smem);
  }
}

__device__ __forceinline__ void modulate_rows(const Params& p, int layer, int it) {
  const int tid = tid_opaque(), lane = tid & 63, w = __builtin_amdgcn_readfirstlane(tid >> 6);
  const float* nw = p.norm_w + layer * DM;
  const float* src[2]; const float* mods[2]; u16* dst[2];
  float4 v[2][4];
#pragma unroll
  for (int rr = 0; rr < 2; ++rr) {
    const int row = it * 8 + w * 2 + rr;
    int bidx;
    if (row < MX) { src[rr] = (layer == 0 ? p.x : p.out) + (size_t)row * DM; bidx = row >> 11; }
    else { src[rr] = (layer == 0 ? p.ctx : reinterpret_cast<const float*>(p.ws + OFF_CTXN)) + (size_t)(row - MX) * DM; bidx = 8; }
    mods[rr] = reinterpret_cast<const float*>(p.ws + OFF_MODS) + ((size_t)layer * 9 + bidx) * 3072;
    dst[rr] = reinterpret_cast<u16*>(p.ws + OFF_HZ) + (size_t)row * DM;
#pragma unroll
    for (int i = 0; i < 4; ++i) v[rr][i] = *reinterpret_cast<const float4*>(src[rr] + (i >> 1) * 512 + lane * 8 + (i & 1) * 4);
  }
#pragma unroll
  for (int rr = 0; rr < 2; ++rr) {
    float ss = 0.f;
#pragma unroll
    for (int i = 0; i < 4; ++i) ss += v[rr][i].x * v[rr][i].x + v[rr][i].y * v[rr][i].y + v[rr][i].z * v[rr][i].z + v[rr][i].w * v[rr][i].w;
#pragma unroll
    for (int o = 1; o < 64; o <<= 1) ss += __shfl_xor(ss, o);
    const float rstd = rsqrtf(ss * (1.0f / 1024.0f) + EPS);
    uint2 oo[4];
#pragma unroll
    for (int i = 0; i < 4; ++i) {
      const int k = (i >> 1) * 512 + lane * 8 + (i & 1) * 4;
      const float4 g = *reinterpret_cast<const float4*>(nw + k);
      const float4 sc = *reinterpret_cast<const float4*>(mods[rr] + 1024 + k);
      const float4 sh = *reinterpret_cast<const float4*>(mods[rr] + k);
      const float a0 = v[rr][i].x * rstd * g.x * (1.f + sc.x) + sh.x;
      const float a1 = v[rr][i].y * rstd * g.y * (1.f + sc.y) + sh.y;
      const float a2 = v[rr][i].z * rstd * g.z * (1.f + sc.z) + sh.z;
      const float a3 = v[rr][i].w * rstd * g.w * (1.f + sc.w) + sh.w;
      oo[i].x = pack2(a0, a1); oo[i].y = pack2(a2, a3);
    }
#pragma unroll
    for (int a = 0; a < 2; ++a) {
      uint4 o4; o4.x = oo[2 * a].x; o4.y = oo[2 * a].y; o4.z = oo[2 * a + 1].x; o4.w = oo[2 * a + 1].y;
      *reinterpret_cast<uint4*>(dst[rr] + a * 512 + lane * 8) = o4;
    }
  }
}

__device__ __forceinline__ int swz4(int r, int c) { return r * 32 + ((c ^ ((0x78 >> (((r >> 2) & 3) * 2)) & 3)) << 3); }

template <int MT, bool SWAP>
__device__ __forceinline__ void gemm_tile(const u16* __restrict__ A, const u16* __restrict__ Bt, int K, int m0, int n0,
                                          u16* lds, f32x4 (&acc)[MT][4]) {
  constexpr int BMR = 2 * MT * 16;
  constexpr int STAGE = (BMR + 128) * 32;
  constexpr int NA = BMR / 64;
  constexpr bool REM = (BMR % 64) != 0;
  const int tid = tid_opaque(), lane = tid & 63, w = __builtin_amdgcn_readfirstlane(tid >> 6), wm = w >> 1, wn = w & 1, fr = lane & 15, fq = lane >> 4;
  const int lr = tid >> 2, lc = tid & 3;
  const u16* Ap = A + (size_t)(m0 + lr) * K + lc * 8;
  const u16* Bp = Bt + (size_t)(n0 + lr) * K + lc * 8;
  uint4 ra0, ra1, ra2, ra3, rax = uint4{0u, 0u, 0u, 0u}, rb0, rb1;
  static_assert(NA == 4, "A panel is loaded as 4 rounds of 64 rows (+32)");
#define G_LOAD(KO) do { \
    ra0 = *reinterpret_cast<const uint4*>(Ap + (KO)); \
    ra1 = *reinterpret_cast<const uint4*>(Ap + (size_t)64 * K + (KO)); \
    ra2 = *reinterpret_cast<const uint4*>(Ap + (size_t)128 * K + (KO)); \
    ra3 = *reinterpret_cast<const uint4*>(Ap + (size_t)192 * K + (KO)); \
    if (REM && w < 2) rax = *reinterpret_cast<const uint4*>(Ap + (size_t)256 * K + (KO)); \
    rb0 = *reinterpret_cast<const uint4*>(Bp + (KO)); \
    rb1 = *reinterpret_cast<const uint4*>(Bp + (size_t)64 * K + (KO)); } while (0)
#define G_STORE(DST) do { u16* d_ = (DST); \
    *reinterpret_cast<uint4*>(d_ + woff) = ra0; \
    *reinterpret_cast<uint4*>(d_ + woff + 64 * 32) = ra1; \
    *reinterpret_cast<uint4*>(d_ + woff + 128 * 32) = ra2; \
    *reinterpret_cast<uint4*>(d_ + woff + 192 * 32) = ra3; \
    if (REM && w < 2) *reinterpret_cast<uint4*>(d_ + woff + 256 * 32) = rax; \
    *reinterpret_cast<uint4*>(d_ + BMR * 32 + woff) = rb0; \
    *reinterpret_cast<uint4*>(d_ + BMR * 32 + woff + 64 * 32) = rb1; } while (0)
  const int woff = swz4(lr, lc);
  G_LOAD(0);
#pragma unroll
  for (int mi = 0; mi < MT; ++mi)
#pragma unroll
    for (int ni = 0; ni < 4; ++ni) acc[mi][ni] = f32x4{0.f, 0.f, 0.f, 0.f};
  G_STORE(lds);
  __syncthreads();
  const int aoff = swz4(wm * MT * 16 + fr, fq);
  const int boff = BMR * 32 + swz4(wn * 64 + fr, fq);
  const int nk = K >> 5;
#pragma unroll 1
  for (int kt = 0; kt < nk; ++kt) {
    const u16* cur = lds + (kt & 1) * STAGE;
    const bool more = (kt + 1) < nk;
    if (more) G_LOAD((kt + 1) * 32);
    bf16x8 bfr[4], af[MT];
#pragma unroll
    for (int ni = 0; ni < 4; ++ni) bfr[ni] = ldfrag(cur + boff + ni * 16 * 32);
#pragma unroll
    for (int mi = 0; mi < MT; ++mi) af[mi] = ldfrag(cur + aoff + mi * 16 * 32);
#pragma unroll
    for (int mi = 0; mi < MT; ++mi)
#pragma unroll
      for (int ni = 0; ni < 4; ++ni) acc[mi][ni] = SWAP ? mfma16(bfr[ni], af[mi], acc[mi][ni]) : mfma16(af[mi], bfr[ni], acc[mi][ni]);
    __builtin_amdgcn_sched_group_barrier(0x100, 7, 0);
#pragma unroll
    for (int i = 0; i < MT - 3; ++i) { __builtin_amdgcn_sched_group_barrier(0x008, 4, 0); __builtin_amdgcn_sched_group_barrier(0x100, 1, 0); }
    __builtin_amdgcn_sched_group_barrier(0x008, 12, 0);
    __builtin_amdgcn_sched_barrier(0);
    if (more) G_STORE(lds + ((kt + 1) & 1) * STAGE);
    __syncthreads();
  }
#undef G_LOAD
#undef G_STORE
}

__device__ __forceinline__ void inproj_tile(const Params& p, int layer, int tile, unsigned char* smem) {
  constexpr int MT = 9;
  const int xcd_ = tile & 7, slot_ = (tile >> 3) & 63, rnd_ = tile >> 9;
  const int pm = xcd_ * 8 + (slot_ >> 3), pn = (slot_ & 7) + 8 * rnd_;
  const int m0 = pm * 288, n0 = pn * 128;
  const u16* A = reinterpret_cast<const u16*>(p.ws + OFF_HZ);
  const u16* Bt = reinterpret_cast<const u16*>(p.ws + OFF_WIN) + (size_t)layer * 4096 * 1024;
  bool tr; int dc;
  if (n0 < 1024) { tr = false; dc = n0; }
  else if (n0 < 1536) { tr = true; dc = n0 - 1024; }
  else if (n0 < 2048) { tr = false; dc = n0 - 512; }
  else if (n0 < 3072) { tr = true; dc = n0 - 2048 + 512; }
  else if (n0 < 3584) { tr = false; dc = n0 - 3072 + 1536; }
  else if (n0 < 3840) { tr = true; dc = n0 - 3584 + 1536; }
  else { tr = false; dc = n0 - 3840 + 2048; }
  f32x4 acc[MT][4];
  if (tr) {
    gemm_tile<MT, false>(A, Bt, 1024, m0, n0, reinterpret_cast<u16*>(smem), acc);
    const int tid = tid_opaque(), lane = tid & 63, w = __builtin_amdgcn_readfirstlane(tid >> 6), wm = w >> 1, wn = w & 1, fr = lane & 15, fq = lane >> 4;
    u16* UT = reinterpret_cast<u16*>(p.ws + OFF_UT);
    typedef unsigned u2_t __attribute__((ext_vector_type(2)));
    const int roff = (fq & 1) ? (16 + (fq - 1) * 4) : (fq * 4);
#pragma unroll
    for (int ni = 0; ni < 4; ++ni) {
      u16* pc = UT + (size_t)(dc + wn * 64 + ni * 16 + fr) * MALL + (m0 + wm * (MT * 16));
#pragma unroll
      for (int a = 0; a < MT / 2; ++a) {
        const unsigned ax = pack2(acc[2 * a][ni][0], acc[2 * a][ni][1]), ay = pack2(acc[2 * a][ni][2], acc[2 * a][ni][3]);
        const unsigned bx = pack2(acc[2 * a + 1][ni][0], acc[2 * a + 1][ni][1]), by = pack2(acc[2 * a + 1][ni][2], acc[2 * a + 1][ni][3]);
        const u2_t sx = __builtin_amdgcn_permlane16_swap(ax, bx, false, false);
        const u2_t sy = __builtin_amdgcn_permlane16_swap(ay, by, false, false);
        uint4 o; o.x = sx.x; o.y = sy.x; o.z = sx.y; o.w = sy.y;
        *reinterpret_cast<uint4*>(pc + a * 32 + roff) = o;
      }
      if (MT & 1) {
        uint2 o; o.x = pack2(acc[MT - 1][ni][0], acc[MT - 1][ni][1]); o.y = pack2(acc[MT - 1][ni][2], acc[MT - 1][ni][3]);
        *reinterpret_cast<uint2*>(pc + (MT - 1) * 16 + fq * 4) = o;
      }
    }
  } else {
    gemm_tile<MT, true>(A, Bt, 1024, m0, n0, reinterpret_cast<u16*>(smem), acc);
    const int tid = tid_opaque(), lane = tid & 63, w = __builtin_amdgcn_readfirstlane(tid >> 6), wm = w >> 1, wn = w & 1, fr = lane & 15, fq = lane >> 4;
    u16* U = reinterpret_cast<u16*>(p.ws + OFF_U);
    typedef unsigned u2_t __attribute__((ext_vector_type(2)));
    const int coff = (fq & 1) ? (16 + (fq - 1) * 4) : (fq * 4);
#pragma unroll
    for (int mi = 0; mi < MT; ++mi) {
      const int row = m0 + wm * (MT * 16) + mi * 16 + fr;
#pragma unroll
      for (int a = 0; a < 2; ++a) {
        const unsigned ax = pack2(acc[mi][2 * a][0], acc[mi][2 * a][1]), ay = pack2(acc[mi][2 * a][2], acc[mi][2 * a][3]);
        const unsigned bx = pack2(acc[mi][2 * a + 1][0], acc[mi][2 * a + 1][1]), by = pack2(acc[mi][2 * a + 1][2], acc[mi][2 * a + 1][3]);
        const u2_t sx = __builtin_amdgcn_permlane16_swap(ax, bx, false, false);
        const u2_t sy = __builtin_amdgcn_permlane16_swap(ay, by, false, false);
        uint4 o; o.x = sx.x; o.y = sy.x; o.z = sx.y; o.w = sy.y;
        *reinterpret_cast<uint4*>(U + (size_t)row * UW + dc + wn * 64 + a * 32 + coff) = o;
      }
    }
  }
}

template <int MT>
__device__ __forceinline__ void outproj_tile(const Params& p, int layer, int tile, unsigned char* smem) {
  const int xcd = tile & 7, slot = tile >> 3;
  const int pm = xcd * 8 + (slot >> 3), pn = slot & 7;
  const int m0 = pm * (MT * 32), n0 = pn * 128;
  f32x4 acc[MT][4];
  gemm_tile<MT, true>(reinterpret_cast<const u16*>(p.ws + OFF_HZ), reinterpret_cast<const u16*>(p.ws + OFF_WOUT) + (size_t)layer * 1024 * 1024, 1024, m0, n0,
                      reinterpret_cast<u16*>(smem), acc);
  const int tid = tid_opaque(), lane = tid & 63, w = __builtin_amdgcn_readfirstlane(tid >> 6), wm = w >> 1, wn = w & 1, fr = lane & 15, fq = lane >> 4;
  const float* mods = reinterpret_cast<const float*>(p.ws + OFF_MODS) + (size_t)layer * 9 * 3072 + 2048;
  const float* xsrc = (layer == 0) ? p.x : p.out;
  float* ctxn = reinterpret_cast<float*>(p.ws + OFF_CTXN);
#pragma unroll
  for (int mi = 0; mi < MT; ++mi) {
    const int row = m0 + wm * (MT * 16) + mi * 16 + fr;
    const bool isx = row < MX;
    const int bidx = isx ? (row >> 11) : 8;
    const float* src = isx ? (xsrc + (size_t)row * DM) : (p.ctx + (size_t)(row - MX) * DM);
    float* dst = isx ? (p.out + (size_t)row * DM) : (ctxn + (size_t)(row - MX) * DM);
    const float* gate = mods + bidx * 3072;
#pragma unroll
    for (int ni = 0; ni < 4; ++ni) {
      const int col = n0 + wn * 64 + ni * 16 + fq * 4;
      const float4 g = *reinterpret_cast<const float4*>(gate + col);
      const float4 xv = *reinterpret_cast<const float4*>(src + col);
      float4 ov;
      ov.x = xv.x + g.x * acc[mi][ni][0]; ov.y = xv.y + g.y * acc[mi][ni][1];
      ov.z = xv.z + g.z * acc[mi][ni][2]; ov.w = xv.w + g.w * acc[mi][ni][3];
      *reinterpret_cast<float4*>(dst + col) = ov;
    }
  }
}

__device__ __forceinline__ void load_qk_norm(const u16* __restrict__ U, int row0, int colbase, const float* __restrict__ gain, float mul, u16* dstlds) {
  const int tid = tid_opaque(), lr = tid >> 3, lc = tid & 7;
  float g[8];
#pragma unroll
  for (int i = 0; i < 8; ++i) g[i] = gain[lc * 8 + i] * mul;
#pragma unroll
  for (int i = 0; i < 2; ++i) {
    int r = lr + 32 * i;
    uint4 v = *reinterpret_cast<const uint4*>(U + (size_t)(row0 + r) * UW + colbase + lc * 8);
    float f[8];
    f[0] = lo16(v.x); f[1] = hi16(v.x); f[2] = lo16(v.y); f[3] = hi16(v.y);
    f[4] = lo16(v.z); f[5] = hi16(v.z); f[6] = lo16(v.w); f[7] = hi16(v.w);
    float ss = 0.f;
#pragma unroll
    for (int k = 0; k < 8; ++k) ss += f[k] * f[k];
    ss += __shfl_xor(ss, 1); ss += __shfl_xor(ss, 2); ss += __shfl_xor(ss, 4);
    float rstd = rsqrtf(ss * (1.0f / 64.0f) + EPS);
    uint4 o;
    o.x = pack2(f[0] * rstd * g[0], f[1] * rstd * g[1]);
    o.y = pack2(f[2] * rstd * g[2], f[3] * rstd * g[3]);
    o.z = pack2(f[4] * rstd * g[4], f[5] * rstd * g[5]);
    o.w = pack2(f[6] * rstd * g[6], f[7] * rstd * g[7]);
    *reinterpret_cast<uint4*>(dstlds + swz(r, lc)) = o;
  }
}

__device__ __forceinline__ void att_store_k(const uint4& v, u16* dst, const float* kg) {
  float f0 = lo16(v.x), f1 = hi16(v.x), f2 = lo16(v.y), f3 = hi16(v.y), f4 = lo16(v.z), f5 = hi16(v.z), f6 = lo16(v.w), f7 = hi16(v.w);
  float ss = f0 * f0 + f1 * f1 + f2 * f2 + f3 * f3 + f4 * f4 + f5 * f5 + f6 * f6 + f7 * f7;
  ss += __shfl_xor(ss, 1); ss += __shfl_xor(ss, 2); ss += __shfl_xor(ss, 4);
  float rstd = rsqrtf(ss * (1.0f / 64.0f) + EPS);
  float4 g0 = *reinterpret_cast<const float4*>(kg), g1 = *reinterpret_cast<const float4*>(kg + 4);
  uint4 ov;
  ov.x = pack2(f0 * rstd * g0.x, f1 * rstd * g0.y);
  ov.y = pack2(f2 * rstd * g0.z, f3 * rstd * g0.w);
  ov.z = pack2(f4 * rstd * g1.x, f5 * rstd * g1.y);
  ov.w = pack2(f6 * rstd * g1.z, f7 * rstd * g1.w);
  *reinterpret_cast<uint4*>(dst) = ov;
}

template <bool LOCAL>
__device__ __forceinline__ void attn_mtile2(const u16* sQw, const u16* sK, const u16* sVT, const float* sBias, const int mi0,
                                            const int fr, const int fq, const int dr, const float negC, f32x4 (&o)[4][4], float (&l)[4]) {
  constexpr int NKT = LOCAL ? 2 : 4;
  int nb[2];
#pragma unroll
  for (int t = 0; t < 2; ++t) { const int mi = mi0 + t; nb[t] = LOCAL ? ((mi == 0) ? 0 : (mi == 1) ? 8 : (mi == 2) ? 24 : 32) : 0; }
  bf16x8 qf[2][2], kf[2][NKT][2];
#pragma unroll
  for (int t = 0; t < 2; ++t) {
    qf[t][0] = ldfrag(sQw + swz((mi0 + t) * 16 + fr, fq));
    qf[t][1] = ldfrag(sQw + swz((mi0 + t) * 16 + fr, 4 + fq));
  }
#pragma unroll
  for (int t = 0; t < (LOCAL ? 2 : 1); ++t)
#pragma unroll
    for (int kt = 0; kt < NKT; ++kt) {
      kf[t][kt][0] = ldfrag(sK + swz(nb[t] + kt * 16 + fr, fq));
      kf[t][kt][1] = ldfrag(sK + swz(nb[t] + kt * 16 + fr, 4 + fq));
    }
  float bv[2][8];
  if (LOCAL) {
#pragma unroll
    for (int t = 0; t < 2; ++t) {
      const float* bl = sBias + dr * 31 + (fq * 4 - fr) + (15 + nb[t] - (mi0 + t) * 16);
#pragma unroll
      for (int kt = 0; kt < 2; ++kt)
#pragma unroll
        for (int j = 0; j < 4; ++j) bv[t][kt * 4 + j] = bl[kt * 16 + j];
    }
  }
  __builtin_amdgcn_sched_barrier(0);
  f32x4 st[2][NKT];
#pragma unroll
  for (int t = 0; t < 2; ++t)
#pragma unroll
    for (int kt = 0; kt < NKT; ++kt) {
      const int tk = LOCAL ? t : 0;
      const float ini = LOCAL ? 0.f : negC;
      st[t][kt] = mfma16(kf[tk][kt][0], qf[t][0], f32x4{ini, ini, ini, ini});
      st[t][kt] = mfma16(kf[tk][kt][1], qf[t][1], st[t][kt]);
    }
  uint2 vlo[2][NKT / 2][4], vhi[2][NKT / 2][4];
#pragma unroll
  for (int t = 0; t < (LOCAL ? 2 : 1); ++t)
#pragma unroll
    for (int a = 0; a < NKT / 2; ++a)
#pragma unroll
      for (int dt = 0; dt < 4; ++dt) {
        const int c0 = (nb[t] >> 3) + 4 * a + (fq >> 1);
        vlo[t][a][dt] = *reinterpret_cast<const uint2*>(sVT + swz(dt * 16 + fr, c0) + (fq & 1) * 4);
        vhi[t][a][dt] = *reinterpret_cast<const uint2*>(sVT + swz(dt * 16 + fr, c0 + 2) + (fq & 1) * 4);
      }
  if (LOCAL) {
#pragma unroll
    for (int t = 0; t < 2; ++t) {
      const int cq = (mi0 + t) * 16 + fr;
      const int cs = min(max(cq - 8, 0), 48);
      const int tt = nb[t] + fq * 4 - cs;
#pragma unroll
      for (int kt = 0; kt < 2; ++kt)
#pragma unroll
        for (int j = 0; j < 4; ++j) {
          const bool ok = (unsigned)(tt + kt * 16 + j) < 16u;
          st[t][kt][j] = ok ? (st[t][kt][j] + bv[t][kt * 4 + j]) : -1e30f;
        }
    }
  }
#pragma unroll
  for (int t = 0; t < 2; ++t) {
    float ps = 0.f;
#pragma unroll
    for (int kt = 0; kt < NKT; ++kt)
#pragma unroll
      for (int j = 0; j < 4; ++j) { const float pv = __builtin_amdgcn_exp2f(st[t][kt][j]); st[t][kt][j] = pv; ps += pv; }
    l[mi0 + t] += ps;
  }
#pragma unroll
  for (int t = 0; t < 2; ++t)
#pragma unroll
    for (int a = 0; a < NKT / 2; ++a) {
      uint4 pk;
      pk.x = pack2(st[t][2 * a][0], st[t][2 * a][1]); pk.y = pack2(st[t][2 * a][2], st[t][2 * a][3]);
      pk.z = pack2(st[t][2 * a + 1][0], st[t][2 * a + 1][1]); pk.w = pack2(st[t][2 * a + 1][2], st[t][2 * a + 1][3]);
      const bf16x8 pf = *reinterpret_cast<bf16x8*>(&pk);
      const int tv = LOCAL ? t : 0;
#pragma unroll
      for (int dt = 0; dt < 4; ++dt) {
        uint4 vv; vv.x = vlo[tv][a][dt].x; vv.y = vlo[tv][a][dt].y; vv.z = vhi[tv][a][dt].x; vv.w = vhi[tv][a][dt].y;
        o[mi0 + t][dt] = mfma16(*reinterpret_cast<bf16x8*>(&vv), pf, o[mi0 + t][dt]);
      }
    }
  __builtin_amdgcn_sched_barrier(0);
}

__device__ __forceinline__ void attn_item(const Params& p, int layer, int item, unsigned char* smem) {
  u16* sKV = reinterpret_cast<u16*>(smem);
  u16* sP = sKV + 16384;
  float* sBias = reinterpret_cast<float*>(smem + 40960);
  float* sKg = sBias + 468;
  u16* sQ = reinterpret_cast<u16*>(smem + 43520);
  const int tid = tid_opaque(), lane = tid & 63, w = __builtin_amdgcn_readfirstlane(tid >> 6), fr = lane & 15, fq = lane >> 4;
  const u16* U = reinterpret_cast<const u16*>(p.ws + OFF_U);
  const u16* UT = reinterpret_cast<const u16*>(p.ws + OFF_UT);
  const bool lat = item < 512;
  int b, h, qrow0, r = 0, R0 = 0, kr_lo = 0, nlocal = 0;
  if (lat) {
    b = item >> 6; h = (item >> 3) & 7; const int g = item & 7;
    r = g * 4 + w; R0 = min(max(r - 4, 0), 24);
    kr_lo = min(max(g * 4 - 4, 0), 24);
    const int kr_hi = min(max(g * 4 + 3 - 4, 0), 24) + 7;
    nlocal = kr_hi - kr_lo + 1;
    qrow0 = b * SEQ + g * 256;
  } else {
    const int it = item - 512; b = it >> 3; h = it & 7; qrow0 = MX + b * LC;
  }
  const float negC = -reinterpret_cast<const float*>(p.ws + OFF_SHIFT)[layer * 2 + (lat ? 1 : 0)];
  if (lat) {
    const float* rp = p.rpb + ((size_t)layer * 8 + h) * 465;
    for (int i = tid; i < 465; i += 256) sBias[i] = rp[i] * 1.4426950408889634f + negC;
  }
  if (tid < 64) sKg[tid] = p.kg[layer * 64 + tid];
#pragma unroll 1
  for (int qq = 0; qq < 4; ++qq) load_qk_norm(U, qrow0 + qq * 64, h * 64, p.qg + layer * 64, 0.125f * 1.4426950408889634f, sQ + qq * 4096);
  __syncthreads();
  f32x4 o[4][4];
  float l[4];
#pragma unroll
  for (int mi = 0; mi < 4; ++mi) {
    l[mi] = 0.f;
#pragma unroll
    for (int j = 0; j < 4; ++j) o[mi][j] = f32x4{0.f, 0.f, 0.f, 0.f};
  }
  u16* sPw = sP + w * 1024;
  const int nch = nlocal + 4;
  const int lr = tid >> 3, lc = tid & 7;
  const int vd = tid >> 2, vpart = tid & 3;
  uint4 rk0, rk1, rv0, rv1;
#define ATT_ISSUE(CH) do { const int ch_ = (CH); \
    const int krow0_ = (ch_ < nlocal) ? (b * SEQ + (kr_lo + ch_) * 64) : (MX + b * LC + (ch_ - nlocal) * 64); \
    rk0 = *reinterpret_cast<const uint4*>(U + (size_t)(krow0_ + lr) * UW + 512 + h * 64 + lc * 8); \
    rk1 = *reinterpret_cast<const uint4*>(U + (size_t)(krow0_ + lr + 32) * UW + 512 + h * 64 + lc * 8); \
    rv0 = *reinterpret_cast<const uint4*>(UT + (size_t)(h * 64 + vd) * MALL + krow0_ + (vpart * 2) * 8); \
    rv1 = *reinterpret_cast<const uint4*>(UT + (size_t)(h * 64 + vd) * MALL + krow0_ + (vpart * 2 + 1) * 8); } while (0)
#define ATT_STORE(BUF) do { u16* dK_ = sKV + (BUF) * 4096; u16* dV_ = sKV + 8192 + (BUF) * 4096; \
    att_store_k(rk0, dK_ + swz(lr, lc), sKg + lc * 8); att_store_k(rk1, dK_ + swz(lr + 32, lc), sKg + lc * 8); \
    *reinterpret_cast<uint4*>(dV_ + swz(vd, vpart * 2)) = rv0; *reinterpret_cast<uint4*>(dV_ + swz(vd, vpart * 2 + 1)) = rv1; } while (0)
  ATT_ISSUE(0);
  ATT_STORE(0);
  __syncthreads();
#pragma unroll 1
  for (int ch = 0; ch < nch; ++ch) {
    const bool more = (ch + 1) < nch;
    if (more) ATT_ISSUE(ch + 1);
    __builtin_amdgcn_sched_barrier(0);
    const bool local = ch < nlocal;
    const int kr = kr_lo + ch;
    const bool active = !local || (kr >= R0 && kr <= R0 + 7);
    const u16* sK = sKV + (ch & 1) * 4096;
    const u16* sVT = sKV + 8192 + (ch & 1) * 4096;
    if (active) {
      int frl = fr, fql = fq;
      asm volatile("" : "+v"(frl), "+v"(fql));
      if (local) {
        const int dr = kr - r + 7;
        attn_mtile2<true>(sQ + w * 4096, sK, sVT, sBias, 0, frl, fql, dr, negC, o, l);
        attn_mtile2<true>(sQ + w * 4096, sK, sVT, sBias, 2, frl, fql, dr, negC, o, l);
      } else {
        attn_mtile2<false>(sQ + w * 4096, sK, sVT, sBias, 0, frl, fql, 0, negC, o, l);
        attn_mtile2<false>(sQ + w * 4096, sK, sVT, sBias, 2, frl, fql, 0, negC, o, l);
      }
    }
    __builtin_amdgcn_sched_barrier(0);
    if (more) ATT_STORE((ch + 1) & 1);
    __syncthreads();
  }
  u16* Z = reinterpret_cast<u16*>(p.ws + OFF_HZ);
#pragma unroll
  for (int mi = 0; mi < 4; ++mi) {
    int fre = fr, fqe = fq;
    asm volatile("" : "+v"(fre), "+v"(fqe) :: "memory");
    float lt = l[mi];
    lt += __shfl_xor(lt, 16);
    lt += __shfl_xor(lt, 32);
    const float inv = 1.0f / lt;
    const int row = qrow0 + w * 64 + mi * 16 + fre;
    typedef unsigned u2a_t __attribute__((ext_vector_type(2)));
    const int coff = (fqe & 1) ? (16 + (fqe - 1) * 4) : (fqe * 4);
    uint2 ovv[4];
#pragma unroll
    for (int dt = 0; dt < 4; ++dt) {
      const int dcol = h * 64 + dt * 16 + fqe * 4;
      uint2 gv = *reinterpret_cast<const uint2*>(U + (size_t)row * UW + 1024 + dcol);
      ovv[dt].x = pack2(o[mi][dt][0] * inv * silu(lo16(gv.x)), o[mi][dt][1] * inv * silu(hi16(gv.x)));
      ovv[dt].y = pack2(o[mi][dt][2] * inv * silu(lo16(gv.y)), o[mi][dt][3] * inv * silu(hi16(gv.y)));
    }
#pragma unroll
    for (int a = 0; a < 2; ++a) {
      const u2a_t sx = __builtin_amdgcn_permlane16_swap(ovv[2 * a].x, ovv[2 * a + 1].x, false, false);
      const u2a_t sy = __builtin_amdgcn_permlane16_swap(ovv[2 * a].y, ovv[2 * a + 1].y, false, false);
      uint4 o4; o4.x = sx.x; o4.y = sy.x; o4.z = sx.y; o4.w = sy.y;
      *reinterpret_cast<uint4*>(Z + (size_t)row * DM + h * 64 + a * 32 + coff) = o4;
    }
  }
  asm volatile("" ::: "memory");
  __syncthreads();
}

template <typename F>
__device__ __forceinline__ void ret_load_rope(const u16* __restrict__ U, int rowbase, int colbase, bool rope, int tpos0, float mul, F&& sink) {
  const int tid = tid_opaque();
#pragma unroll
  for (int i = 0; i < 2; ++i) {
    int id = tid + 256 * i;
    int l = id >> 2, pr = id & 3;
    int c = (pr & 1) + ((pr >> 1) << 2);
    const u16* src = U + (size_t)(rowbase + l) * UW + colbase + c * 8;
    uint4 v1 = *reinterpret_cast<const uint4*>(src);
    uint4 v2 = *reinterpret_cast<const uint4*>(src + 16);
    float x1[8], x2[8];
    x1[0] = lo16(v1.x); x1[1] = hi16(v1.x); x1[2] = lo16(v1.y); x1[3] = hi16(v1.y);
    x1[4] = lo16(v1.z); x1[5] = hi16(v1.z); x1[6] = lo16(v1.w); x1[7] = hi16(v1.w);
    x2[0] = lo16(v2.x); x2[1] = hi16(v2.x); x2[2] = lo16(v2.y); x2[3] = hi16(v2.y);
    x2[4] = lo16(v2.z); x2[5] = hi16(v2.z); x2[6] = lo16(v2.w); x2[7] = hi16(v2.w);
    float o1[8], o2[8];
    if (rope) {
      int t = tpos0 + l;
      float pos = (float)((c >= 4) ? (t & 63) : (t >> 6));
#pragma unroll
      for (int k = 0; k < 8; ++k) {
        int fi = (c & 1) * 8 + k;
        float freq = exp2f(-(float)fi * (13.287712379549449f / 16.0f));
        float ang = pos * freq;
        float sn, cs; sincos_rr(ang, sn, cs);
        o1[k] = (x1[k] * cs - x2[k] * sn) * mul;
        o2[k] = (x1[k] * sn + x2[k] * cs) * mul;
      }
    } else {
#pragma unroll
      for (int k = 0; k < 8; ++k) { o1[k] = x1[k] * mul; o2[k] = x2[k] * mul; }
    }
    sink(l, c, o1, o2);
  }
}

__device__ __forceinline__ void ret_load_vt(const u16* __restrict__ UT, int h, int rowbase, u16* sVT) {
  const int tid = tid_opaque();
  int e = tid >> 2, part = tid & 3;
#pragma unroll
  for (int i = 0; i < 4; ++i) {
    int kg = part * 4 + i;
    uint4 v = *reinterpret_cast<const uint4*>(UT + (size_t)(1536 + h * 64 + e) * MALL + rowbase + kg * 8);
    *reinterpret_cast<uint4*>(sVT + (kg >> 3) * 4096 + swz(e, kg & 7)) = v;
  }
}

__device__ __forceinline__ void retkv_item(const Params& p, int layer, int item, unsigned char* smem) {
  u16* sVT = reinterpret_cast<u16*>(smem);
  u16* sKf = sVT + 8192;
  u16* sKb = sVT + 16384;
  const int tid = tid_opaque(), lane = tid & 63, w = __builtin_amdgcn_readfirstlane(tid >> 6), fr = lane & 15, fq = lane >> 4;
  const int ci = item % 18, bh = item / 18, h = bh & 3, b = bh >> 2;
  const bool lat = ci < 16;
  const int rowbase = lat ? (b * SEQ + ci * 128) : (MX + b * LC + (ci - 16) * 128);
  const float lgf = -__expf(p.rlr[layer * 8 + h]), lgb = -__expf(p.rlr[layer * 8 + 4 + h]);
  const u16* U = reinterpret_cast<const u16*>(p.ws + OFF_U);
  const u16* UT = reinterpret_cast<const u16*>(p.ws + OFF_UT);
  ret_load_vt(UT, h, rowbase, sVT);
  ret_load_rope(U, rowbase, 1792 + h * 64, lat, ci * 128, 0.125f, [&](int l, int c, float* o1, float* o2) {
    float wf = __expf(lgf * (float)(127 - l)), wb = __expf(lgb * (float)l);
    int pan = (l >> 6) * 4096, kc = (l & 63) >> 3, e7 = l & 7;
#pragma unroll
    for (int k = 0; k < 8; ++k) {
      int d1 = c * 8 + k, d2 = d1 + 16;
      sKf[pan + swz(d1, kc) + e7] = f2bf(o1[k] * wf);
      sKf[pan + swz(d2, kc) + e7] = f2bf(o2[k] * wf);
      sKb[pan + swz(d1, kc) + e7] = f2bf(o1[k] * wb);
      sKb[pan + swz(d2, kc) + e7] = f2bf(o2[k] * wb);
    }
  });
  __syncthreads();
  f32x4 acc[2][4];
#pragma unroll
  for (int d = 0; d < 2; ++d)
#pragma unroll
    for (int ni = 0; ni < 4; ++ni) acc[d][ni] = f32x4{0.f, 0.f, 0.f, 0.f};
#pragma unroll
  for (int ks = 0; ks < 4; ++ks) {
    int pan = (ks >> 1) * 4096, kc = (ks & 1) * 4 + fq;
    bf16x8 a = ldfrag(sVT + pan + swz(w * 16 + fr, kc));
#pragma unroll
    for (int ni = 0; ni < 4; ++ni) {
      bf16x8 bf_ = ldfrag(sKf + pan + swz(ni * 16 + fr, kc));
      bf16x8 bb_ = ldfrag(sKb + pan + swz(ni * 16 + fr, kc));
      acc[0][ni] = mfma16(a, bf_, acc[0][ni]);
      acc[1][ni] = mfma16(a, bb_, acc[1][ni]);
    }
  }
  float* dst = reinterpret_cast<float*>(p.ws + OFF_RKV) + (size_t)item * 2 * 4096;
#pragma unroll
  for (int d = 0; d < 2; ++d)
#pragma unroll
    for (int ni = 0; ni < 4; ++ni)
#pragma unroll
      for (int j = 0; j < 4; ++j) dst[d * 4096 + (w * 16 + fq * 4 + j) * 64 + ni * 16 + fr] = acc[d][ni][j];
  __syncthreads();
}

__device__ __forceinline__ void retout_item(const Params& p, int layer, int item, unsigned char* smem) {
  u16* sQ = reinterpret_cast<u16*>(smem);
  u16* sK = sQ + 8192;
  u16* sVT = sQ + 16384;
  u16* sPf = sQ + 24576;
  u16* sPb = sQ + 28672;
  u16* sP = sQ;
  const int tid = tid_opaque(), lane = tid & 63, w = __builtin_amdgcn_readfirstlane(tid >> 6), fr = lane & 15, fq = lane >> 4;
  const int ci = item % 18, bh = item / 18, h = bh & 3, b = bh >> 2;
  const bool lat = ci < 16;
  const int rowbase = lat ? (b * SEQ + ci * 128) : (MX + b * LC + (ci - 16) * 128);
  const float lgf = -__expf(p.rlr[layer * 8 + h]), lgb = -__expf(p.rlr[layer * 8 + 4 + h]);
  const u16* U = reinterpret_cast<const u16*>(p.ws + OFF_U);
  const u16* UT = reinterpret_cast<const u16*>(p.ws + OFF_UT);
  ret_load_vt(UT, h, rowbase, sVT);
  ret_load_rope(U, rowbase, 1536 + h * 64, lat, ci * 128, 1.0f, [&](int l, int c, float* o1, float* o2) {
    uint4 a, bq;
    a.x = pack2(o1[0], o1[1]); a.y = pack2(o1[2], o1[3]); a.z = pack2(o1[4], o1[5]); a.w = pack2(o1[6], o1[7]);
    bq.x = pack2(o2[0], o2[1]); bq.y = pack2(o2[2], o2[3]); bq.z = pack2(o2[4], o2[5]); bq.w = pack2(o2[6], o2[7]);
    *reinterpret_cast<uint4*>(sQ + swz(l, c)) = a;
    *reinterpret_cast<uint4*>(sQ + swz(l, c + 2)) = bq;
  });
  ret_load_rope(U, rowbase, 1792 + h * 64, lat, ci * 128, 0.125f, [&](int l, int c, float* o1, float* o2) {
    uint4 a, bq;
    a.x = pack2(o1[0], o1[1]); a.y = pack2(o1[2], o1[3]); a.z = pack2(o1[4], o1[5]); a.w = pack2(o1[6], o1[7]);
    bq.x = pack2(o2[0], o2[1]); bq.y = pack2(o2[2], o2[3]); bq.z = pack2(o2[4], o2[5]); bq.w = pack2(o2[6], o2[7]);
    *reinterpret_cast<uint4*>(sK + swz(l, c)) = a;
    *reinterpret_cast<uint4*>(sK + swz(l, c + 2)) = bq;
  });
  {
    const float* kvb = reinterpret_cast<const float*>(p.ws + OFF_RKV) + (size_t)bh * 18 * 2 * 4096;
    const int e = tid >> 2, d0 = (tid & 3) * 16;
    float af[16], ab[16];
#pragma unroll
    for (int i = 0; i < 16; ++i) { af[i] = 0.f; ab[i] = 0.f; }
    const int nsrc = lat ? 19 : 1;
#pragma unroll 1
    for (int kb = 0; kb < nsrc; kb += 4) {
      float4 v[4][4];
      float wgt[4];
      int dirs[4];
#pragma unroll
      for (int u = 0; u < 4; ++u) {
        const int k = kb + u;
        int m = 0, dir = 0; float wv = 0.f;
        if (lat) {
          if (k < ci) { m = k; dir = 0; wv = __expf(lgf * 128.f * (float)(ci - 1 - k)); }
          else if (k == ci) { m = 16; dir = 0; wv = __expf(lgf * 128.f * (float)(ci + 1)); }
          else if (k == ci + 1) { m = 17; dir = 0; wv = __expf(lgf * 128.f * (float)ci); }
          else if (k < 19) {
            const int q = k - (ci + 2);
            dir = 1;
            if (q < 15 - ci) { m = ci + 1 + q; wv = __expf(lgb * 128.f * (float)q); }
            else if (q == 15 - ci) { m = 16; wv = __expf(lgb * 128.f * (float)(15 - ci)); }
            else { m = 17; wv = __expf(lgb * 128.f * (float)(16 - ci)); }
          }
        } else if (k == 0) {
          if (ci == 16) { m = 17; dir = 1; wv = 1.f; } else { m = 16; dir = 0; wv = 1.f; }
        }
        wgt[u] = wv; dirs[u] = dir;
        const float* sp = kvb + ((size_t)m * 2 + dir) * 4096 + e * 64 + d0;
#pragma unroll
        for (int i = 0; i < 4; ++i) v[u][i] = *reinterpret_cast<const float4*>(sp + i * 4);
      }
      __builtin_amdgcn_sched_barrier(0);
#pragma unroll
      for (int u = 0; u < 4; ++u) {
        const float wf = dirs[u] == 0 ? wgt[u] : 0.f, wb = dirs[u] == 0 ? 0.f : wgt[u];
#pragma unroll
        for (int i = 0; i < 4; ++i) {
          af[i * 4 + 0] += wf * v[u][i].x; af[i * 4 + 1] += wf * v[u][i].y; af[i * 4 + 2] += wf * v[u][i].z; af[i * 4 + 3] += wf * v[u][i].w;
          ab[i * 4 + 0] += wb * v[u][i].x; ab[i * 4 + 1] += wb * v[u][i].y; ab[i * 4 + 2] += wb * v[u][i].z; ab[i * 4 + 3] += wb * v[u][i].w;
        }
      }
    }
#pragma unroll
    for (int hf = 0; hf < 2; ++hf) {
      uint4 a, bq;
      a.x = pack2(af[hf * 8 + 0], af[hf * 8 + 1]); a.y = pack2(af[hf * 8 + 2], af[hf * 8 + 3]); a.z = pack2(af[hf * 8 + 4], af[hf * 8 + 5]); a.w = pack2(af[hf * 8 + 6], af[hf * 8 + 7]);
      bq.x = pack2(ab[hf * 8 + 0], ab[hf * 8 + 1]); bq.y = pack2(ab[hf * 8 + 2], ab[hf * 8 + 3]); bq.z = pack2(ab[hf * 8 + 4], ab[hf * 8 + 5]); bq.w = pack2(ab[hf * 8 + 6], ab[hf * 8 + 7]);
      *reinterpret_cast<uint4*>(sPf + swz(e, (d0 >> 3) + hf)) = a;
      *reinterpret_cast<uint4*>(sPb + swz(e, (d0 >> 3) + hf)) = bq;
    }
  }
  __syncthreads();
  f32x4 S[2][8], Of[2][4], Ob[2][4];
#pragma unroll
  for (int mi = 0; mi < 2; ++mi) {
#pragma unroll
    for (int ni = 0; ni < 8; ++ni) S[mi][ni] = f32x4{0.f, 0.f, 0.f, 0.f};
#pragma unroll
    for (int ni = 0; ni < 4; ++ni) { Of[mi][ni] = f32x4{0.f, 0.f, 0.f, 0.f}; Ob[mi][ni] = f32x4{0.f, 0.f, 0.f, 0.f}; }
  }
#pragma unroll
  for (int ks = 0; ks < 2; ++ks) {
    bf16x8 qa[2];
#pragma unroll
    for (int mi = 0; mi < 2; ++mi) qa[mi] = ldfrag(sQ + swz(w * 32 + mi * 16 + fr, ks * 4 + fq));
#pragma unroll
    for (int ni = 0; ni < 8; ++ni) {
      bf16x8 kf = ldfrag(sK + swz(ni * 16 + fr, ks * 4 + fq));
#pragma unroll
      for (int mi = 0; mi < 2; ++mi) S[mi][ni] = mfma16(qa[mi], kf, S[mi][ni]);
    }
#pragma unroll
    for (int ni = 0; ni < 4; ++ni) {
      bf16x8 pf = ldfrag(sPf + swz(ni * 16 + fr, ks * 4 + fq));
      bf16x8 pb = ldfrag(sPb + swz(ni * 16 + fr, ks * 4 + fq));
#pragma unroll
      for (int mi = 0; mi < 2; ++mi) { Of[mi][ni] = mfma16(pf, qa[mi], Of[mi][ni]); Ob[mi][ni] = mfma16(pb, qa[mi], Ob[mi][ni]); }
    }
  }
  __syncthreads();
#pragma unroll
  for (int mi = 0; mi < 2; ++mi)
#pragma unroll
    for (int ni = 0; ni < 8; ++ni) {
      int lcol = ni * 16 + fr;
#pragma unroll
      for (int j = 0; j < 4; ++j) {
        int jrow = w * 32 + mi * 16 + fq * 4 + j;
        int diff = jrow - lcol;
        float dd = 0.f;
        if (diff >= 0) dd += __expf(lgf * (float)diff);
        if (diff <= 0) dd += __expf(lgb * (float)(-diff));
        sP[(lcol >> 6) * 8192 + swz(jrow, (lcol & 63) >> 3) + (lcol & 7)] = f2bf(S[mi][ni][j] * dd);
      }
    }
  __syncthreads();
  f32x4 O[2][4];
#pragma unroll
  for (int mi = 0; mi < 2; ++mi)
#pragma unroll
    for (int ni = 0; ni < 4; ++ni) O[mi][ni] = f32x4{0.f, 0.f, 0.f, 0.f};
#pragma unroll
  for (int ks = 0; ks < 4; ++ks) {
    int kc = (ks & 1) * 4 + fq;
    bf16x8 pa[2];
#pragma unroll
    for (int mi = 0; mi < 2; ++mi) pa[mi] = ldfrag(sP + (ks >> 1) * 8192 + swz(w * 32 + mi * 16 + fr, kc));
#pragma unroll
    for (int ni = 0; ni < 4; ++ni) {
      bf16x8 vf = ldfrag(sVT + (ks >> 1) * 4096 + swz(ni * 16 + fr, kc));
#pragma unroll
      for (int mi = 0; mi < 2; ++mi) O[mi][ni] = mfma16(vf, pa[mi], O[mi][ni]);
    }
  }
  u16* Z = reinterpret_cast<u16*>(p.ws + OFF_HZ);
#pragma unroll
  for (int mi = 0; mi < 2; ++mi) {
    const int jrow = w * 32 + mi * 16 + fr;
    const float xf = __expf(lgf * (float)(jrow + 1)), xb = __expf(lgb * (float)(128 - jrow));
    float v[4][4], ss = 0.f;
#pragma unroll
    for (int ni = 0; ni < 4; ++ni)
#pragma unroll
      for (int j = 0; j < 4; ++j) { v[ni][j] = O[mi][ni][j] + xf * Of[mi][ni][j] + xb * Ob[mi][ni][j]; ss += v[ni][j] * v[ni][j]; }
    ss += __shfl_xor(ss, 16);
    ss += __shfl_xor(ss, 32);
    const float rstd = rsqrtf(ss * (1.0f / 64.0f) + EPS);
    const int row = rowbase + jrow;
#pragma unroll
    for (int ni = 0; ni < 4; ++ni) {
      const int e = ni * 16 + fq * 4;
      const uint2 gv = *reinterpret_cast<const uint2*>(U + (size_t)row * UW + 2048 + h * 64 + e);
      uint2 ov;
      ov.x = pack2(v[ni][0] * rstd * silu(lo16(gv.x)), v[ni][1] * rstd * silu(hi16(gv.x)));
      ov.y = pack2(v[ni][2] * rstd * silu(lo16(gv.y)), v[ni][3] * rstd * silu(hi16(gv.y)));
      *reinterpret_cast<uint2*>(Z + (size_t)row * DM + 768 + h * 64 + e) = ov;
    }
  }
  __syncthreads();
}

__device__ __forceinline__ float block_sum(float v, float* red) {
#pragma unroll
  for (int o = 1; o < 64; o <<= 1) v += __shfl_xor(v, o);
  __syncthreads();
  if ((threadIdx.x & 63) == 0) red[threadIdx.x >> 6] = v;
  __syncthreads();
  return red[0] + red[1] + red[2] + red[3];
}

struct HyRaw { uint4 v; u16 e0, e1; };
template <int LX>
__device__ __forceinline__ HyRaw hy_load8(const u16* __restrict__ s, int tc) {
  HyRaw r;
  r.v = *reinterpret_cast<const uint4*>(s);
  r.e0 = (tc > 0) ? s[-1] : (u16)0;
  r.e1 = (tc < LX / 8 - 1) ? s[8] : (u16)0;
  return r;
}
__device__ __forceinline__ void hy_eval8(const HyRaw& r, float w0, float w1, float w2, float bb, float* o) {
  float f[10];
  f[0] = bf2f(r.e0);
  f[1] = lo16(r.v.x); f[2] = hi16(r.v.x); f[3] = lo16(r.v.y); f[4] = hi16(r.v.y);
  f[5] = lo16(r.v.z); f[6] = hi16(r.v.z); f[7] = lo16(r.v.w); f[8] = hi16(r.v.w);
  f[9] = bf2f(r.e1);
#pragma unroll
  for (int i = 0; i < 8; ++i) o[i] = w0 * f[i] + w1 * f[i + 1] + w2 * f[i + 2] + bb;
}

template <int LX, int NT>
__device__ __forceinline__ void hyena_item(const Params& p, int layer, int c, unsigned char* smem) {
  constexpr int T1 = LX / 32;
  constexpr int RSTR = 2 * LX + 32;
  u16* sU = reinterpret_cast<u16*>(smem);
  u16* sR = sU + 16384 + 256;
  float* red = reinterpret_cast<float*>(smem + 32768 + 512 + 4 * (2 * SEQ + 32) * 2);
  const int tid = tid_opaque(), lane = tid & 63, w = __builtin_amdgcn_readfirstlane(tid >> 6), fr = lane & 15, fq = lane >> 4;
  const int rowbase = (LX == SEQ) ? 0 : MX;
  const u16* UT = reinterpret_cast<const u16*>(p.ws + OFF_UT);
  const float* filt = (LX == SEQ) ? (reinterpret_cast<const float*>(p.ws + OFF_FILT) + (size_t)layer * 1024 * SEQ) : reinterpret_cast<const float*>(p.ws + OFF_FILTC);
  const float* cw = p.cw + layer * 3 * 768;
  const float* cb = p.cb + layer * 768;
  u16* Z = reinterpret_cast<u16*>(p.ws + OFF_HZ);
  constexpr int NTAP = (2 * LX - 1 + 255) / 256;
  float taps[NTAP];
  {
    const float* ff = filt + (size_t)(0 * 256 + c) * LX;
    const float* fb = filt + (size_t)(1 * 256 + c) * LX;
#pragma unroll
    for (int i = 0; i < NTAP; ++i) {
      const int y = tid + 256 * i;
      taps[i] = (y < LX) ? ff[LX - 1 - y] : ((y < 2 * LX - 1) ? fb[y - (LX - 1)] : 0.f);
    }
  }
  if (tid < 32) { unsigned zz; asm volatile("v_mov_b32 %0, 0" : "=v"(zz)); *reinterpret_cast<uint4*>(sU + (T1 * 4 * 8) * 8 + tid * 8) = uint4{zz, zz, zz, zz}; }
  {
    const float w0 = cw[c], w1 = cw[768 + c], w2 = cw[1536 + c], bb = cb[c];
    const u16* src = UT + (size_t)(512 + c) * MALL + rowbase;
    constexpr int NIT = LX / 256;
    constexpr int NBT = (NIT < 4) ? NIT : 4;
#pragma unroll 1
    for (int it0 = 0; it0 < NIT; it0 += NBT) {
      HyRaw raw[NBT];
#pragma unroll
      for (int it = 0; it < NBT; ++it) { const int id = tid + 256 * (it0 + it); const int b = id / (LX / 8), tc = id % (LX / 8); raw[it] = hy_load8<LX>(src + b * LX + tc * 8, tc); }
      __builtin_amdgcn_sched_barrier(0);
#pragma unroll
      for (int it = 0; it < NBT; ++it) {
        const int id = tid + 256 * (it0 + it); const int b = id / (LX / 8), tc = id % (LX / 8);
        float o[8];
        hy_eval8(raw[it], w0, w1, w2, bb, o);
        uint4 ov; ov.x = pack2(o[0], o[1]); ov.y = pack2(o[2], o[3]); ov.z = pack2(o[4], o[5]); ov.w = pack2(o[6], o[7]);
        *reinterpret_cast<uint4*>(sU + (tc * 8 + b) * 8) = ov;
      }
    }
  }
  const int t1lo = w * NT * 2;
#pragma unroll 1
  for (int ord = 0; ord < 2; ++ord) {
    {
      float sa = 0.f;
#pragma unroll
      for (int i = 0; i < NTAP; ++i) sa += fabsf(taps[i]);
      float tot = block_sum(sa, red);
      float inv = 1.0f / tot;
#pragma unroll
      for (int i = 0; i < NTAP; ++i) {
        const int y = tid + 256 * i;
        if (y < 2 * LX - 1) {
          u16 hv = f2bf(taps[i] * inv);
          sR[y] = hv;
          if (y >= 1) sR[RSTR + y - 1] = hv;
          if (y >= 2) sR[2 * RSTR + y - 2] = hv;
          if (y >= 3) sR[3 * RSTR + y - 3] = hv;
        }
      }
    }
    __syncthreads();
    if (ord == 0) {
      const float* ff = filt + (size_t)(2 * 256 + c) * LX;
      const float* fb = filt + (size_t)(3 * 256 + c) * LX;
#pragma unroll
      for (int i = 0; i < NTAP; ++i) {
        const int y = tid + 256 * i;
        taps[i] = (y < LX) ? ff[LX - 1 - y] : ((y < 2 * LX - 1) ? fb[y - (LX - 1)] : 0.f);
      }
    }
    f32x4 acc[2][NT];
#pragma unroll
    for (int mi = 0; mi < 2; ++mi)
#pragma unroll
      for (int ni = 0; ni < NT; ++ni) acc[mi][ni] = f32x4{0.f, 0.f, 0.f, 0.f};
    const int d1lo = t1lo - (T1 - 1), d1hi = t1lo + NT * 2 - 1;
    bf16x8 a0[2], b0[NT], a1[2], b1[NT];
    int ubase[NT];
#pragma unroll
    for (int ni = 0; ni < NT; ++ni) ubase[ni] = (w * NT + ni) * 16 + fr;
#define HY_LOAD(D1, AF, BF) do { const int d1_ = (D1); \
      _Pragma("unroll") for (int mi = 0; mi < 2; ++mi) { \
        int y0 = (LX - 1) - (32 * d1_ + mi * 16 + fr - fq * 8); int sh = y0 & 3; \
        const u16* q = sR + sh * RSTR + (y0 - sh); \
        uint2 lo = *reinterpret_cast<const uint2*>(q); uint2 hi = *reinterpret_cast<const uint2*>(q + 4); \
        uint4 pk; pk.x = lo.x; pk.y = lo.y; pk.z = hi.x; pk.w = hi.y; AF[mi] = *reinterpret_cast<bf16x8*>(&pk); } \
      _Pragma("unroll") for (int ni = 0; ni < NT; ++ni) { \
        int t1s = (ubase[ni] >> 3) - d1_; \
        t1s = ((unsigned)t1s < (unsigned)T1) ? t1s : T1; \
        BF[ni] = ldfrag(sU + ((4 * t1s + fq) * 8 + (ubase[ni] & 7)) * 8); } } while (0)
#define HY_MMA(AF, BF) do { \
      _Pragma("unroll") for (int ni = 0; ni < NT; ++ni) \
        _Pragma("unroll") for (int mi = 0; mi < 2; ++mi) acc[mi][ni] = mfma16(AF[mi], BF[ni], acc[mi][ni]); } while (0)
    HY_LOAD(d1lo, a0, b0);
#pragma unroll 1
    for (int d1 = d1lo; d1 <= d1hi; d1 += 2) {
      HY_LOAD(min(d1 + 1, d1hi), a1, b1);
      HY_MMA(a0, b0);
      HY_LOAD(min(d1 + 2, d1hi), a0, b0);
      if (d1 + 1 <= d1hi) HY_MMA(a1, b1);
    }
#undef HY_MMA
#undef HY_LOAD
    __syncthreads();
    {
      int fr_e = fr, fq_e = fq;
      asm volatile("" : "+v"(fr_e), "+v"(fq_e));
      const float skipv = p.skip[(layer * 2 + ord) * 256 + c];
#pragma unroll
      for (int ni = 0; ni < NT; ++ni) {
        int n = (w * NT + ni) * 16 + fr_e;
        int t1 = n >> 3, b = n & 7;
#pragma unroll
        for (int mi = 0; mi < 2; ++mi) {
          int t = 32 * t1 + mi * 16 + fq_e * 4;
          u16* up = sU + (((t >> 3) * 8 + b) * 8 + (t & 7));
          uint2 uv = *reinterpret_cast<const uint2*>(up);
          uint2 ov;
          ov.x = pack2(acc[mi][ni][0] + lo16(uv.x) * skipv, acc[mi][ni][1] + hi16(uv.x) * skipv);
          ov.y = pack2(acc[mi][ni][2] + lo16(uv.y) * skipv, acc[mi][ni][3] + hi16(uv.y) * skipv);
          *reinterpret_cast<uint2*>(up) = ov;
        }
      }
    }
    __syncthreads();
    {
      const int gch = (ord == 0) ? (768 + c) : (1024 + c);
      const int cwi = (ord == 0) ? (256 + c) : (512 + c);
      const float w0 = cw[cwi], w1 = cw[768 + cwi], w2 = cw[1536 + cwi], bb = cb[cwi];
      const u16* src = UT + (size_t)gch * MALL + rowbase;
      const u16* ghs = UT + (size_t)(1280 + c) * MALL + rowbase;
      constexpr int NIT = LX / 256;
      constexpr int NBT = (NIT < 4) ? NIT : 4;
#pragma unroll 1
      for (int it0 = 0; it0 < NIT; it0 += NBT) {
        HyRaw raw[NBT];
        uint4 ghv[NBT];
#pragma unroll
        for (int it = 0; it < NBT; ++it) {
          const int id = tid + 256 * (it0 + it); const int b = id / (LX / 8), tc = id % (LX / 8);
          raw[it] = hy_load8<LX>(src + b * LX + tc * 8, tc);
          ghv[it] = (ord == 1) ? *reinterpret_cast<const uint4*>(ghs + b * LX + tc * 8) : uint4{0u, 0u, 0u, 0u};
        }
        __builtin_amdgcn_sched_barrier(0);
#pragma unroll
        for (int it = 0; it < NBT; ++it) {
          const int id = tid + 256 * (it0 + it); const int b = id / (LX / 8), tc = id % (LX / 8);
          float g[8];
          hy_eval8(raw[it], w0, w1, w2, bb, g);
          u16* up = sU + (tc * 8 + b) * 8;
          uint4 uv = *reinterpret_cast<const uint4*>(up);
          float y[8] = {lo16(uv.x), hi16(uv.x), lo16(uv.y), hi16(uv.y), lo16(uv.z), hi16(uv.z), lo16(uv.w), hi16(uv.w)};
          if (ord == 0) {
            uint4 ov;
            ov.x = pack2(y[0] * g[0], y[1] * g[1]); ov.y = pack2(y[2] * g[2], y[3] * g[3]);
            ov.z = pack2(y[4] * g[4], y[5] * g[5]); ov.w = pack2(y[6] * g[6], y[7] * g[7]);
            *reinterpret_cast<uint4*>(up) = ov;
          } else {
            const uint4 hv = ghv[it];
            float hg[8] = {lo16(hv.x), hi16(hv.x), lo16(hv.y), hi16(hv.y), lo16(hv.z), hi16(hv.z), lo16(hv.w), hi16(hv.w)};
            u16* zp = Z + (size_t)(rowbase + b * LX + tc * 8) * DM + 512 + c;
#pragma unroll
            for (int j = 0; j < 8; ++j) zp[(size_t)j * DM] = f2bf(y[j] * g[j] * silu(hg[j]));
          }
        }
      }
    }
    __syncthreads();
  }
}

__device__ __forceinline__ void run_phase(const Params& p, int ph, unsigned char* smem, int only);
constexpr int LDS_BYTES = 77824;
__device__ __forceinline__ void run_phase(const Params& p, int ph, unsigned char* smem, int only) {
  const int nb = gridDim.x, bid = blockIdx.x;
#ifndef MIX_REP
#define MIX_REP 0
#endif
#ifndef PH_MASK
#define PH_MASK 0xff
#endif
  if (ph == 0) {
    if (PH_MASK & 1) for (int it = bid; it < 1938; it += nb) { if (it < 2) prep_softmax_shift(p, it, smem); else prep_item(p, 1937 - it, smem); }
    return;
  }
  const int layer = (ph - 1) / 5, sub = (ph - 1) % 5;
  if (sub == 0) {
    if (PH_MASK & 2) {
      if (nb == 512) {
        const int x = bid & 7, sl = bid >> 3;
        for (int k = sl; k < 288; k += 64) modulate_rows(p, layer, x * 288 + k);
      } else {
        for (int it = bid; it < MALL / 8; it += nb) modulate_rows(p, layer, it);
      }
    }
  } else if (sub == 1) {
    if (PH_MASK & 4) for (int it = bid; it < 64 * 32; it += nb) inproj_tile(p, layer, it, smem);
  } else if (sub == 2) {
    if (PH_MASK & 8) for (int it = bid; it < 576; it += nb) retkv_item(p, layer, it, smem);
  } else if (sub == 3) {
    const int half = nb >> 1;
    for (int step = 0;; ++step) {
      int kind = -1, idx = 0;
      if (bid < half) {
        const int i = bid + (step >> 1) * half;
        if (i >= 256) break;
        if (step & 1) { kind = 1; idx = 256 + i; } else { kind = 0; idx = ((i & 7) << 5) | (i >> 3); }
      } else {
        const int q = step / 6, sub = step - q * 6;
        const int j = (bid - half) + q * half;
        if (j >= 256) break;
        if (sub == 0) { kind = 1; idx = j; }
        else if (sub == 1) { if (layer == 0 && (j < 64 || j >= 128)) { kind = 2; idx = j; } }
        else if (sub == 2 || sub == 3) { const int r2 = 2 * j + (sub - 2); kind = 3; idx = (r2 >> 4) * 18 + (r2 & 15); }
        else if (sub == 4) { if (layer == 0 && j < 64) { kind = 1; idx = 512 + j; } else if (layer == 0 && j >= 128 && j < 192) { kind = 2; idx = j - 64; } }
        else { if (layer == 0 && j >= 64 && j < 128) { kind = 3; idx = ((j - 64) >> 1) * 18 + 16 + ((j - 64) & 1); } }
      }
      if (kind < 0) continue;
      if (only >= 0 && only != kind) continue;
      if (kind == 0) { if (PH_MASK & 16) hyena_item<SEQ, 8>(p, layer, idx, smem); }
      else if (kind == 1) { if (PH_MASK & 64) attn_item(p, layer, idx, smem); }
      else if (kind == 2) { if (PH_MASK & 16) hyena_item<LC, 1>(p, layer, idx, smem); }
      else { if (PH_MASK & 32) retout_item(p, layer, idx, smem); }
    }
  } else {
    if (PH_MASK & 128) {
      if (layer == 0) { for (int it = bid; it < 512; it += nb) outproj_tile<9>(p, layer, it, smem); }
      else { for (int it = bid; it < 512; it += nb) outproj_tile<8>(p, layer, it, smem); }
    }
  }
}

#define XB_TMO      128
#define XB_XCNT(j)  (256  + 64 * (j))
#define XB_XSUB(j)  (1280 + 64 * (j))
#define XB_XGEN(j)  (2304 + 64 * (j))
#define XB_TOP      3328
#define XB_TOPGEN   3392
#define XCD_BAR_WORDS 3456
#define XB_SPIN_CAP (1u << 22)
__device__ __forceinline__ unsigned xb_ld(unsigned* p)              { return __hip_atomic_load(p, __ATOMIC_RELAXED, __HIP_MEMORY_SCOPE_AGENT); }
__device__ __forceinline__ unsigned xb_add(unsigned* p, unsigned v) { return __hip_atomic_fetch_add(p, v, __ATOMIC_RELAXED, __HIP_MEMORY_SCOPE_AGENT); }
__device__ __forceinline__ unsigned xb_xcc_id() { return (unsigned)__builtin_amdgcn_s_getreg((3 << 11) | 20) & 0xFu; }
#define XB_SPIN(cond, bar) do { unsigned _sp = 0; while (cond) { __builtin_amdgcn_s_sleep(1); \
    if ((++_sp & 255u) == 0u) { if (xb_ld(&(bar)[XB_TMO])) break; if (_sp > XB_SPIN_CAP) { atomicAdd(&(bar)[XB_TMO], 1u); break; } } } } while (0)
struct XcdBarrier { unsigned* bar; unsigned x; volatile unsigned* st; };
__device__ __forceinline__ void xcd_barrier_complete(unsigned* bar, unsigned x, unsigned& nloc, unsigned& nx) {
  const unsigned G = gridDim.x * gridDim.y * gridDim.z;
  unsigned sum, cnt, mine, sp = 0u;
  for (;;) {
    sum = 0u; cnt = 0u; mine = 0u;
#pragma unroll
    for (unsigned j = 0; j < 16; ++j) { const unsigned c = xb_ld(&bar[XB_XCNT(j)]); sum += c; cnt += (c > 0u) ? 1u : 0u; mine = (j == x) ? c : mine; }
    if (sum == G) break;
    __builtin_amdgcn_s_sleep(1);
    if ((++sp & 255u) == 0u) { if (xb_ld(&bar[XB_TMO])) break; if (sp > XB_SPIN_CAP) { atomicAdd(&bar[XB_TMO], 1u); break; } }
  }
  nloc = mine > 0u ? mine : 1u; nx = cnt > 0u ? cnt : 1u;
}
__device__ __forceinline__ void xcd_barrier(XcdBarrier& b) {
  asm volatile("s_waitcnt vmcnt(0)" ::: "memory");
  __syncthreads();
  if (threadIdx.x == 0) {
    unsigned* bar = b.bar;
    __builtin_amdgcn_s_waitcnt(0);
    unsigned nloc = b.st[0], nx = b.st[1];
    if (nloc == 0u) { xcd_barrier_complete(bar, b.x, nloc, nx); b.st[0] = nloc; b.st[1] = nx; }
    const unsigned old = xb_add(&bar[XB_XSUB(b.x)], 1u);
    const unsigned gen = old / nloc;
    if (old + 1u == (gen + 1u) * nloc) {
      __builtin_amdgcn_fence(__ATOMIC_RELEASE, "agent");
      asm volatile("s_waitcnt vmcnt(0)" ::: "memory");
      const unsigned og = xb_add(&bar[XB_TOP], 1u);
      const unsigned tg = og / nx;
      if (og + 1u == (tg + 1u) * nx) xb_add(&bar[XB_TOPGEN], 1u);
      else XB_SPIN(xb_ld(&bar[XB_TOPGEN]) == tg, bar);
      __builtin_amdgcn_fence(__ATOMIC_ACQUIRE, "agent");
      xb_add(&bar[XB_XGEN(b.x)], 1u);
      asm volatile("s_waitcnt vmcnt(0)" ::: "memory");
    } else {
      XB_SPIN(xb_ld(&bar[XB_XGEN(b.x)]) == gen, bar);
      __builtin_amdgcn_fence(__ATOMIC_ACQUIRE, "agent");
      asm volatile("s_waitcnt vmcnt(0)" ::: "memory");
    }
  }
  __syncthreads();
}

constexpr int NPHASE = 11;

__global__ void __launch_bounds__(256, 2) mega_kernel(Params p, int ph_lo, int ph_hi, int use_cg) {
  extern __shared__ __attribute__((aligned(16))) unsigned char smem[];
  XcdBarrier xb;
  xb.bar = reinterpret_cast<unsigned*>(p.ws + OFF_BAR); xb.x = xb_xcc_id(); xb.st = reinterpret_cast<volatile unsigned*>(smem + LDS_BYTES - 16);
  if (threadIdx.x == 0) { xb.st[0] = 0u; xb.st[1] = 0u; }
  __syncthreads();
  if (!use_cg && ph_hi - ph_lo > 1 && threadIdx.x == 0) (void)xb_add(&xb.bar[XB_XCNT(xb.x)], 1u);
  for (int ph = ph_lo; ph < ph_hi; ++ph) {
    int nrep = 1;
#ifdef REP_MASK
    {
      int kind = (ph == 0) ? 0 : 1 + (ph - 1) % 5;
      if (((REP_MASK >> kind) & 1) && !(kind == 5 && ph > 5)) nrep = 2;
    }
#endif
#ifndef REP_ONLY
#define REP_ONLY -1
#endif
#pragma unroll 1
    for (int rep = 0; rep < nrep; ++rep) run_phase(p, ph, smem, rep == 0 ? -1 : REP_ONLY);
    if (ph + 1 < ph_hi) {
      if (use_cg) cg::this_grid().sync();
      else xcd_barrier(xb);
    }
  }
}

extern "C" void kernel_launch(void* const* d_in, const int* in_sizes, int n_in, void* d_out, int out_size, void* d_ws, size_t ws_size,
                              hipStream_t stream) {
  static int grid_blocks = 0;
  if (!grid_blocks) {
    int dev = 0, cus = 0, per_cu = 0;
    hipGetDevice(&dev);
    hipDeviceGetAttribute(&cus, hipDeviceAttributeMultiprocessorCount, dev);
    hipFuncSetAttribute((const void*)mega_kernel, hipFuncAttributeMaxDynamicSharedMemorySize, LDS_BYTES);
    hipOccupancyMaxActiveBlocksPerMultiprocessor(&per_cu, mega_kernel, 256, LDS_BYTES);
    if (per_cu < 1) per_cu = 1;
    if (per_cu > 2) per_cu = 2;
    grid_blocks = cus * per_cu;
    if (ws_size < WS_END) fprintf(stderr, "kernel_launch: workspace too small (%zu < %zu)\n", ws_size, (size_t)WS_END);
  }
  Params p{};
  const float** pp = reinterpret_cast<const float**>(&p);
  for (int i = 0; i < 22; ++i) pp[i] = (const float*)d_in[i];
  p.out = (float*)d_out;
  p.ws = (unsigned char*)d_ws;
#if COOP
  hipMemsetAsync((unsigned char*)d_ws + OFF_BAR, 0, 16384, stream);
  int lo = 0, hi = NPHASE, ucg = 0;
  void* args[] = {&p, &lo, &hi, &ucg};
  hipError_t e = hipLaunchCooperativeKernel((void*)mega_kernel, dim3(grid_blocks), dim3(256), args, LDS_BYTES, stream);
  if (e != hipSuccess) fprintf(stderr, "cooperative launch failed: %s (grid %d)\n", hipGetErrorString(e), grid_blocks);
#else
  for (int ph = 0; ph < NPHASE; ++ph) hipLaunchKernelGGL(mega_kernel, dim3(grid_blocks), dim3(256), LDS_BYTES, stream, p, ph, ph + 1, 0);
#endif
}
```

```cpp
#include <hip/hip_runtime.h>
#include <hip/hip_cooperative_groups.h>
#include <cstdio>
#include <cstdint>
namespace cg = cooperative_groups;

#ifndef COOP
#define COOP 1
#endif

typedef unsigned short u16;
typedef short bf16x8 __attribute__((ext_vector_type(8)));
typedef float f32x4 __attribute__((ext_vector_type(4)));

constexpr int NB = 8, SEQ = 2048, LC = 256, DM = 1024, MX = 16384, MC = 2048, MALL = 18432;
constexpr int UW = 2304;
constexpr float EPS = 1e-6f;

constexpr size_t OFF_WIN = 0;
constexpr size_t OFF_WOUT = 16777216;
constexpr size_t OFF_MODS_OLD = 20971520;
constexpr size_t OFF_HZ = 21192704;
constexpr size_t OFF_U = 58941440;
constexpr size_t OFF_UT = 143876096;
constexpr size_t OFF_CTXN = 209936384;
constexpr size_t OFF_FILT = 218324992;
constexpr size_t OFF_FILTC = 235102208;
constexpr size_t OFF_RKV = 236150784;
constexpr size_t OFF_BAR = 255025152;
constexpr size_t OFF_MODS = 255025152 + 16384;
constexpr size_t ZERO_BYTES = 16384 + 221184;
constexpr size_t OFF_SHIFT = OFF_MODS + 221184;
constexpr size_t WS_END = OFF_SHIFT + 256;

struct Params {
  const float *x, *c, *ctx, *cctx, *norm_w, *ada_w, *ada_b, *w_in, *w_out, *qg, *kg, *rpb, *cw, *cb,
      *hw1, *hb1, *hw2, *hb2, *hw3, *sf, *skip, *rlr;
  float* out;
  unsigned char* ws;
};

typedef float f32x2_t __attribute__((ext_vector_type(2)));
typedef __bf16 bf16x2_t __attribute__((ext_vector_type(2)));
__device__ __forceinline__ unsigned pack2(float a, float b) {
  f32x2_t v = {a, b};
  bf16x2_t r = __builtin_convertvector(v, bf16x2_t);
  return __builtin_bit_cast(unsigned, r);
}
__device__ __forceinline__ u16 f2bf(float f) { return (u16)(pack2(f, f) & 0xffffu); }
__device__ __forceinline__ float bf2f(u16 h) { return __uint_as_float(((unsigned)h) << 16); }
__device__ __forceinline__ float lo16(unsigned v) { return __uint_as_float(v << 16); }
__device__ __forceinline__ float hi16(unsigned v) { return __uint_as_float(v & 0xffff0000u); }
__device__ __forceinline__ void sincos_rr(float a, float& sn, float& cs) {
  float k = rintf(a * 0.15915494309189535f);
  float r = fmaf(-k, 6.2831854820251465f, a);
  r = fmaf(-k, -1.7484555e-7f, r);
  sn = __sinf(r); cs = __cosf(r);
}
__device__ __forceinline__ float sin_rr(float a) { float s, c; sincos_rr(a, s, c); return s; }
__device__ __forceinline__ int tid_opaque() { int t = threadIdx.x; asm volatile("" : "+v"(t)); return t; }
__device__ __forceinline__ float silu(float v) { return v / (1.f + __expf(-v)); }
__device__ __forceinline__ int swz(int r, int kc) { return r * 64 + ((kc ^ ((r >> 1) & 7)) << 3); }
__device__ __forceinline__ bf16x8 ldfrag(const u16* p) { return *reinterpret_cast<const bf16x8*>(p); }
__device__ __forceinline__ f32x4 mfma16(bf16x8 a, bf16x8 b, f32x4 c) { return __builtin_amdgcn_mfma_f32_16x16x32_bf16(a, b, c, 0, 0, 0); }
__device__ __forceinline__ float red16_sum(float v) {
  v += __shfl_xor(v, 1); v += __shfl_xor(v, 2); v += __shfl_xor(v, 4); v += __shfl_xor(v, 8); return v;
}
__device__ __forceinline__ float red16_max(float v) {
  v = fmaxf(v, __shfl_xor(v, 1)); v = fmaxf(v, __shfl_xor(v, 2)); v = fmaxf(v, __shfl_xor(v, 4)); v = fmaxf(v, __shfl_xor(v, 8)); return v;
}

__device__ __forceinline__ void prep_transpose(const float* __restrict__ W, int N, u16* __restrict__ WT, int K, int kt, int nt, unsigned char* smem) {
  float* tile = reinterpret_cast<float*>(smem);
  const int tid = tid_opaque();
  float4 v[8];
#pragma unroll
  for (int i = 0; i < 8; ++i) {
    int r = (tid >> 5) + 8 * i, c4 = (tid & 31) * 4;
    v[i] = *reinterpret_cast<const float4*>(W + (size_t)(kt * 64 + r) * N + nt * 128 + c4);
  }
#pragma unroll
  for (int i = 0; i < 8; ++i) {
    int r = (tid >> 5) + 8 * i, c4 = (tid & 31) * 4;
    tile[r * 129 + c4 + 0] = v[i].x; tile[r * 129 + c4 + 1] = v[i].y; tile[r * 129 + c4 + 2] = v[i].z; tile[r * 129 + c4 + 3] = v[i].w;
  }
  __syncthreads();
#pragma unroll
  for (int i = 0; i < 4; ++i) {
    int n = (tid >> 3) + 32 * i, k8 = (tid & 7) * 8;
    uint4 o;
    o.x = pack2(tile[(k8 + 0) * 129 + n], tile[(k8 + 1) * 129 + n]);
    o.y = pack2(tile[(k8 + 2) * 129 + n], tile[(k8 + 3) * 129 + n]);
    o.z = pack2(tile[(k8 + 4) * 129 + n], tile[(k8 + 5) * 129 + n]);
    o.w = pack2(tile[(k8 + 6) * 129 + n], tile[(k8 + 7) * 129 + n]);
    *reinterpret_cast<uint4*>(WT + (size_t)(nt * 128 + n) * K + kt * 64 + k8) = o;
  }
  __syncthreads();
}

__device__ __forceinline__ void prep_mods(const Params& p, int layer, int cg, unsigned char* smem) {
  float* sc = reinterpret_cast<float*>(smem);
  float* red = sc + 9 * 1024;
  const int tid = tid_opaque();
  for (int i = tid; i < 9 * 1024; i += 256) {
    int r = i >> 10, k = i & 1023;
    float v = (r < 8) ? p.c[r * 1024 + k] : p.cctx[k];
    sc[i] = silu(v);
  }
  __syncthreads();
  const int col = tid & 15, ks = tid >> 4;
  const float* w = p.ada_w + (size_t)layer * 1024 * 3072 + (size_t)(ks * 64) * 3072 + cg * 16 + col;
  float acc[9];
#pragma unroll
  for (int r = 0; r < 9; ++r) acc[r] = 0.f;
#pragma unroll 1
  for (int kb = 0; kb < 64; kb += 32) {
    float wv[32];
#pragma unroll
    for (int k = 0; k < 32; ++k) wv[k] = w[(size_t)(kb + k) * 3072];
#pragma unroll
    for (int k = 0; k < 32; ++k)
#pragma unroll
      for (int r = 0; r < 9; ++r) acc[r] += sc[r * 1024 + ks * 64 + kb + k] * wv[k];
  }
#pragma unroll
  for (int r = 0; r < 9; ++r) red[(ks * 9 + r) * 16 + col] = acc[r];
  __syncthreads();
  float* mods = reinterpret_cast<float*>(p.ws + OFF_MODS);
  if (tid < 144) {
    int r = tid >> 4, cc = tid & 15;
    float sm = 0.f;
#pragma unroll
    for (int q = 0; q < 16; ++q) sm += red[(q * 9 + r) * 16 + cc];
    int n = cg * 16 + cc;
    mods[((size_t)layer * 9 + r) * 3072 + n] = sm + p.ada_b[layer * 3072 + n];
  }
  __syncthreads();
}

__device__ __forceinline__ void prep_softmax_shift(const Params& p, int layer, unsigned char* smem) {
  float* red = reinterpret_cast<float*>(smem);
  const int tid = tid_opaque();
  float mq = 0.f, mk = 0.f, mb = 0.f;
  if (tid < 64) { mq = fabsf(p.qg[layer * 64 + tid]); mk = fabsf(p.kg[layer * 64 + tid]); }
  for (int i = tid; i < 8 * 465; i += 256) mb = fmaxf(mb, fabsf(p.rpb[(size_t)layer * 8 * 465 + i]));
#pragma unroll
  for (int o = 1; o < 64; o <<= 1) { mq = fmaxf(mq, __shfl_xor(mq, o)); mk = fmaxf(mk, __shfl_xor(mk, o)); mb = fmaxf(mb, __shfl_xor(mb, o)); }
  if ((tid & 63) == 0) { red[(tid >> 6) * 3] = mq; red[(tid >> 6) * 3 + 1] = mk; red[(tid >> 6) * 3 + 2] = mb; }
  __syncthreads();
  if (tid == 0) {
    float a = fmaxf(fmaxf(red[0], red[3]), fmaxf(red[6], red[9]));
    float b = fmaxf(fmaxf(red[1], red[4]), fmaxf(red[7], red[10]));
    float c = fmaxf(fmaxf(red[2], red[5]), fmaxf(red[8], red[11]));
    float* dst = reinterpret_cast<float*>(p.ws + OFF_SHIFT);
    dst[layer * 2 + 0] = 8.0f * a * b * 1.4426950408889634f;
    dst[layer * 2 + 1] = (8.0f * a * b + c) * 1.4426950408889634f;
  }
  __syncthreads();
}

__device__ __forceinline__ void prep_filter(const Params& p, int layer, int Lx, int pb, float* __restrict__ dst, unsigned char* smem) {
  float* h1 = reinterpret_cast<float*>(smem);
  float* h2 = h1 + 1024;
  float* sw1 = h2 + 1024;
  float* sw2 = sw1 + 17 * 64;
  float* sb = sw2 + 4096;
  const int tid = tid_opaque();
  const int pp = tid >> 4, j0 = (tid & 15) * 4;
  const int pos = pb * 16 + pp;
  const float* w3 = p.hw3 + (size_t)layer * 64 * 1024;
  for (int i = tid; i < 17 * 64; i += 256) sw1[i] = p.hw1[layer * 17 * 64 + i];
  for (int i = tid; i < 4096; i += 256) sw2[i] = p.hw2[layer * 4096 + i];
  if (tid < 64) { sb[tid] = p.hb1[layer * 64 + tid]; sb[64 + tid] = p.hb2[layer * 64 + tid]; }
  if (tid < 128) sb[128 + tid] = p.sf[layer * 128 + tid];
  __syncthreads();
  {
    float z[17];
    float t = (float)pos / (float)(Lx - 1);
    float omega = 6.283185307179586f * (float)pos / (float)Lx;
    z[0] = t;
#pragma unroll
    for (int k = 0; k < 8; ++k) {
      float band = 1e-4f + (float)k * ((7.0f - 1e-4f) / 7.0f);
      float a = band * omega;
      float sn, cs; sincos_rr(a, sn, cs);
      z[1 + k] = cs;
      z[9 + k] = -sn;
    }
#pragma unroll
    for (int jj = 0; jj < 4; ++jj) {
      int j = j0 + jj;
      float sacc = sb[j];
#pragma unroll
      for (int k = 0; k < 17; ++k) sacc += z[k] * sw1[k * 64 + j];
      h1[pp * 64 + j] = sin_rr(sb[128 + j] * sacc);
    }
  }
  __syncthreads();
  {
    float sacc[4];
#pragma unroll
    for (int jj = 0; jj < 4; ++jj) sacc[jj] = sb[64 + j0 + jj];
#pragma unroll 8
    for (int k = 0; k < 64; ++k) {
      const float hv = h1[pp * 64 + k];
      const float4 wv = *reinterpret_cast<const float4*>(sw2 + k * 64 + j0);
      sacc[0] += hv * wv.x; sacc[1] += hv * wv.y; sacc[2] += hv * wv.z; sacc[3] += hv * wv.w;
    }
#pragma unroll
    for (int jj = 0; jj < 4; ++jj) h2[pp * 64 + j0 + jj] = sin_rr(sb[192 + j0 + jj] * sacc[jj]);
  }
  __syncthreads();
#pragma unroll 1
  for (int q = 0; q < 4; ++q) {
    int col = tid + 256 * q;
    float acc[16];
#pragma unroll
    for (int i = 0; i < 16; ++i) acc[i] = 0.f;
#pragma unroll 1
    for (int kb = 0; kb < 64; kb += 32) {
      float wv[32];
#pragma unroll
      for (int k = 0; k < 32; ++k) wv[k] = w3[(kb + k) * 1024 + col];
#pragma unroll
      for (int k4 = 0; k4 < 8; ++k4) {
        asm volatile("" ::: "memory");
#pragma unroll
        for (int i = 0; i < 16; ++i) {
          const float4 hv = *reinterpret_cast<const float4*>(h2 + i * 64 + kb + k4 * 4);
          acc[i] += hv.x * wv[k4 * 4] + hv.y * wv[k4 * 4 + 1] + hv.z * wv[k4 * 4 + 2] + hv.w * wv[k4 * 4 + 3];
        }
      }
    }
    int cch = col & 255;
    const float d0 = 3.0701134573253944f, d1 = 15.350567286626973f;
    float delta = d0 + (float)cch * ((d1 - d0) / 255.0f);
    float* o = dst + (size_t)col * Lx + pb * 16;
#pragma unroll
    for (int i = 0; i < 16; i += 4) {
      float4 v;
      float t0 = (float)(pb * 16 + i + 0) / (float)(Lx - 1), t1 = (float)(pb * 16 + i + 1) / (float)(Lx - 1);
      float t2 = (float)(pb * 16 + i + 2) / (float)(Lx - 1), t3 = (float)(pb * 16 + i + 3) / (float)(Lx - 1);
      v.x = acc[i + 0] * __expf(-t0 * delta); v.y = acc[i + 1] * __expf(-t1 * delta);
      v.z = acc[i + 2] * __expf(-t2 * delta); v.w = acc[i + 3] * __expf(-t3 * delta);
      *reinterpret_cast<float4*>(o + i) = v;
    }
  }
  __syncthreads();
}

__device__ __forceinline__ void prep_item(const Params& p, int it, unsigned char* smem) {
  if (it < 1024) {
    int layer = it >> 9, r = it & 511, kt = r >> 5, nt = r & 31;
    prep_transpose(p.w_in + (size_t)layer * 1024 * 4096, 4096, reinterpret_cast<u16*>(p.ws + OFF_WIN) + (size_t)layer * 4096 * 1024, 1024, kt, nt, smem);
  } else if (it < 1280) {
    int r = it - 1024; int layer = r >> 7; r &= 127; int kt = r >> 3, nt = r & 7;
    prep_transpose(p.w_out + (size_t)layer * 1024 * 1024, 1024, reinterpret_cast<u16*>(p.ws + OFF_WOUT) + (size_t)layer * 1024 * 1024, 1024, kt, nt, smem);
  } else if (it < 1664) {
    int r = it - 1280; prep_mods(p, r / 192, r % 192, smem);
  } else {
    int r = it - 1664;
    if (r < 256) prep_filter(p, r >> 7, SEQ, r & 127, reinterpret_cast<float*>(p.ws + OFF_FILT) + (size_t)(r >> 7) * 1024 * SEQ, smem);
    else prep_filter(p, 0, LC, r - 256, reinterpret_cast<float*>(p.ws + OFF_FILTC), smem);
  }
}

__device__ __forceinline__ void modulate_rows(const Params& p, int layer, int it) {
  const int tid = tid_opaque(), lane = tid & 63, w = __builtin_amdgcn_readfirstlane(tid >> 6);
  const float* nw = p.norm_w + layer * DM;
  const float* src[2]; const float* mods[2]; u16* dst[2];
  float4 v[2][4];
#pragma unroll
  for (int rr = 0; rr < 2; ++rr) {
    const int row = it * 8 + w * 2 + rr;
    int bidx;
    if (row < MX) { src[rr] = (layer == 0 ? p.x : p.out) + (size_t)row * DM; bidx = row >> 11; }
    else { src[rr] = (layer == 0 ? p.ctx : reinterpret_cast<const float*>(p.ws + OFF_CTXN)) + (size_t)(row - MX) * DM; bidx = 8; }
    mods[rr] = reinterpret_cast<const float*>(p.ws + OFF_MODS) + ((size_t)layer * 9 + bidx) * 3072;
    dst[rr] = reinterpret_cast<u16*>(p.ws + OFF_HZ) + (size_t)row * DM;
#pragma unroll
    for (int i = 0; i < 4; ++i) v[rr][i] = *reinterpret_cast<const float4*>(src[rr] + (i >> 1) * 512 + lane * 8 + (i & 1) * 4);
  }
#pragma unroll
  for (int rr = 0; rr < 2; ++rr) {
    float ss = 0.f;
#pragma unroll
    for (int i = 0; i < 4; ++i) ss += v[rr][i].x * v[rr][i].x + v[rr][i].y * v[rr][i].y + v[rr][i].z * v[rr][i].z + v[rr][i].w * v[rr][i].w;
#pragma unroll
    for (int o = 1; o < 64; o <<= 1) ss += __shfl_xor(ss, o);
    const float rstd = rsqrtf(ss * (1.0f / 1024.0f) + EPS);
    uint2 oo[4];
#pragma unroll
    for (int i = 0; i < 4; ++i) {
      const int k = (i >> 1) * 512 + lane * 8 + (i & 1) * 4;
      const float4 g = *reinterpret_cast<const float4*>(nw + k);
      const float4 sc = *reinterpret_cast<const float4*>(mods[rr] + 1024 + k);
      const float4 sh = *reinterpret_cast<const float4*>(mods[rr] + k);
      const float a0 = v[rr][i].x * rstd * g.x * (1.f + sc.x) + sh.x;
      const float a1 = v[rr][i].y * rstd * g.y * (1.f + sc.y) + sh.y;
      const float a2 = v[rr][i].z * rstd * g.z * (1.f + sc.z) + sh.z;
      const float a3 = v[rr][i].w * rstd * g.w * (1.f + sc.w) + sh.w;
      oo[i].x = pack2(a0, a1); oo[i].y = pack2(a2, a3);
    }
#pragma unroll
    for (int a = 0; a < 2; ++a) {
      uint4 o4; o4.x = oo[2 * a].x; o4.y = oo[2 * a].y; o4.z = oo[2 * a + 1].x; o4.w = oo[2 * a + 1].y;
      *reinterpret_cast<uint4*>(dst[rr] + a * 512 + lane * 8) = o4;
    }
  }
}

__device__ __forceinline__ int swz4(int r, int c) { return r * 32 + ((c ^ ((0x78 >> (((r >> 2) & 3) * 2)) & 3)) << 3); }

template <int MT, bool SWAP>
__device__ __forceinline__ void gemm_tile(const u16* __restrict__ A, const u16* __restrict__ Bt, int K, int m0, int n0,
                                          u16* lds, f32x4 (&acc)[MT][4]) {
  constexpr int BMR = 2 * MT * 16;
  constexpr int STAGE = (BMR + 128) * 32;
  constexpr int NA = BMR / 64;
  constexpr bool REM = (BMR % 64) != 0;
  const int tid = tid_opaque(), lane = tid & 63, w = __builtin_amdgcn_readfirstlane(tid >> 6), wm = w >> 1, wn = w & 1, fr = lane & 15, fq = lane >> 4;
  const int lr = tid >> 2, lc = tid & 3;
  const u16* Ap = A + (size_t)(m0 + lr) * K + lc * 8;
  const u16* Bp = Bt + (size_t)(n0 + lr) * K + lc * 8;
  uint4 ra0, ra1, ra2, ra3, rax = uint4{0u, 0u, 0u, 0u}, rb0, rb1;
  static_assert(NA == 4, "A panel is loaded as 4 rounds of 64 rows (+32)");
#define G_LOAD(KO) do { \
    ra0 = *reinterpret_cast<const uint4*>(Ap + (KO)); \
    ra1 = *reinterpret_cast<const uint4*>(Ap + (size_t)64 * K + (KO)); \
    ra2 = *reinterpret_cast<const uint4*>(Ap + (size_t)128 * K + (KO)); \
    ra3 = *reinterpret_cast<const uint4*>(Ap + (size_t)192 * K + (KO)); \
    if (REM && w < 2) rax = *reinterpret_cast<const uint4*>(Ap + (size_t)256 * K + (KO)); \
    rb0 = *reinterpret_cast<const uint4*>(Bp + (KO)); \
    rb1 = *reinterpret_cast<const uint4*>(Bp + (size_t)64 * K + (KO)); } while (0)
#define G_STORE(DST) do { u16* d_ = (DST); \
    *reinterpret_cast<uint4*>(d_ + woff) = ra0; \
    *reinterpret_cast<uint4*>(d_ + woff + 64 * 32) = ra1; \
    *reinterpret_cast<uint4*>(d_ + woff + 128 * 32) = ra2; \
    *reinterpret_cast<uint4*>(d_ + woff + 192 * 32) = ra3; \
    if (REM && w < 2) *reinterpret_cast<uint4*>(d_ + woff + 256 * 32) = rax; \
    *reinterpret_cast<uint4*>(d_ + BMR * 32 + woff) = rb0; \
    *reinterpret_cast<uint4*>(d_ + BMR * 32 + woff + 64 * 32) = rb1; } while (0)
  const int woff = swz4(lr, lc);
  G_LOAD(0);
#pragma unroll
  for (int mi = 0; mi < MT; ++mi)
#pragma unroll
    for (int ni = 0; ni < 4; ++ni) acc[mi][ni] = f32x4{0.f, 0.f, 0.f, 0.f};
  G_STORE(lds);
  __syncthreads();
  const int aoff = swz4(wm * MT * 16 + fr, fq);
  const int boff = BMR * 32 + swz4(wn * 64 + fr, fq);
  const int nk = K >> 5;
#pragma unroll 1
  for (int kt = 0; kt < nk; ++kt) {
    const u16* cur = lds + (kt & 1) * STAGE;
    const bool more = (kt + 1) < nk;
    if (more) G_LOAD((kt + 1) * 32);
    bf16x8 bfr[4], af[MT];
#pragma unroll
    for (int ni = 0; ni < 4; ++ni) bfr[ni] = ldfrag(cur + boff + ni * 16 * 32);
#pragma unroll
    for (int mi = 0; mi < MT; ++mi) af[mi] = ldfrag(cur + aoff + mi * 16 * 32);
#pragma unroll
    for (int mi = 0; mi < MT; ++mi)
#pragma unroll
      for (int ni = 0; ni < 4; ++ni) acc[mi][ni] = SWAP ? mfma16(bfr[ni], af[mi], acc[mi][ni]) : mfma16(af[mi], bfr[ni], acc[mi][ni]);
    __builtin_amdgcn_sched_group_barrier(0x100, 7, 0);
#pragma unroll
    for (int i = 0; i < MT - 3; ++i) { __builtin_amdgcn_sched_group_barrier(0x008, 4, 0); __builtin_amdgcn_sched_group_barrier(0x100, 1, 0); }
    __builtin_amdgcn_sched_group_barrier(0x008, 12, 0);
    __builtin_amdgcn_sched_barrier(0);
    if (more) G_STORE(lds + ((kt + 1) & 1) * STAGE);
    __syncthreads();
  }
#undef G_LOAD
#undef G_STORE
}

__device__ __forceinline__ void inproj_tile(const Params& p, int layer, int tile, unsigned char* smem) {
  constexpr int MT = 9;
  const int xcd_ = tile & 7, slot_ = (tile >> 3) & 63, rnd_ = tile >> 9;
  const int pm = xcd_ * 8 + (slot_ >> 3), pn = (slot_ & 7) + 8 * rnd_;
  const int m0 = pm * 288, n0 = pn * 128;
  const u16* A = reinterpret_cast<const u16*>(p.ws + OFF_HZ);
  const u16* Bt = reinterpret_cast<const u16*>(p.ws + OFF_WIN) + (size_t)layer * 4096 * 1024;
  bool tr; int dc;
  if (n0 < 1024) { tr = false; dc = n0; }
  else if (n0 < 1536) { tr = true; dc = n0 - 1024; }
  else if (n0 < 2048) { tr = false; dc = n0 - 512; }
  else if (n0 < 3072) { tr = true; dc = n0 - 2048 + 512; }
  else if (n0 < 3584) { tr = false; dc = n0 - 3072 + 1536; }
  else if (n0 < 3840) { tr = true; dc = n0 - 3584 + 1536; }
  else { tr = false; dc = n0 - 3840 + 2048; }
  f32x4 acc[MT][4];
  if (tr) {
    gemm_tile<MT, false>(A, Bt, 1024, m0, n0, reinterpret_cast<u16*>(smem), acc);
    const int tid = tid_opaque(), lane = tid & 63, w = __builtin_amdgcn_readfirstlane(tid >> 6), wm = w >> 1, wn = w & 1, fr = lane & 15, fq = lane >> 4;
    u16* UT = reinterpret_cast<u16*>(p.ws + OFF_UT);
    typedef unsigned u2_t __attribute__((ext_vector_type(2)));
    const int roff = (fq & 1) ? (16 + (fq - 1) * 4) : (fq * 4);
#pragma unroll
    for (int ni = 0; ni < 4; ++ni) {
      u16* pc = UT + (size_t)(dc + wn * 64 + ni * 16 + fr) * MALL + (m0 + wm * (MT * 16));
#pragma unroll
      for (int a = 0; a < MT / 2; ++a) {
        const unsigned ax = pack2(acc[2 * a][ni][0], acc[2 * a][ni][1]), ay = pack2(acc[2 * a][ni][2], acc[2 * a][ni][3]);
        const unsigned bx = pack2(acc[2 * a + 1][ni][0], acc[2 * a + 1][ni][1]), by = pack2(acc[2 * a + 1][ni][2], acc[2 * a + 1][ni][3]);
        const u2_t sx = __builtin_amdgcn_permlane16_swap(ax, bx, false, false);
        const u2_t sy = __builtin_amdgcn_permlane16_swap(ay, by, false, false);
        uint4 o; o.x = sx.x; o.y = sy.x; o.z = sx.y; o.w = sy.y;
        *reinterpret_cast<uint4*>(pc + a * 32 + roff) = o;
      }
      if (MT & 1) {
        uint2 o; o.x = pack2(acc[MT - 1][ni][0], acc[MT - 1][ni][1]); o.y = pack2(acc[MT - 1][ni][2], acc[MT - 1][ni][3]);
        *reinterpret_cast<uint2*>(pc + (MT - 1) * 16 + fq * 4) = o;
      }
    }
  } else {
    gemm_tile<MT, true>(A, Bt, 1024, m0, n0, reinterpret_cast<u16*>(smem), acc);
    const int tid = tid_opaque(), lane = tid & 63, w = __builtin_amdgcn_readfirstlane(tid >> 6), wm = w >> 1, wn = w & 1, fr = lane & 15, fq = lane >> 4;
    u16* U = reinterpret_cast<u16*>(p.ws + OFF_U);
    typedef unsigned u2_t __attribute__((ext_vector_type(2)));
    const int coff = (fq & 1) ? (16 + (fq - 1) * 4) : (fq * 4);
#pragma unroll
    for (int mi = 0; mi < MT; ++mi) {
      const int row = m0 + wm * (MT * 16) + mi * 16 + fr;
#pragma unroll
      for (int a = 0; a < 2; ++a) {
        const unsigned ax = pack2(acc[mi][2 * a][0], acc[mi][2 * a][1]), ay = pack2(acc[mi][2 * a][2], acc[mi][2 * a][3]);
        const unsigned bx = pack2(acc[mi][2 * a + 1][0], acc[mi][2 * a + 1][1]), by = pack2(acc[mi][2 * a + 1][2], acc[mi][2 * a + 1][3]);
        const u2_t sx = __builtin_amdgcn_permlane16_swap(ax, bx, false, false);
        const u2_t sy = __builtin_amdgcn_permlane16_swap(ay, by, false, false);
        uint4 o; o.x = sx.x; o.y = sy.x; o.z = sx.y; o.w = sy.y;
        *reinterpret_cast<uint4*>(U + (size_t)row * UW + dc + wn * 64 + a * 32 + coff) = o;
      }
    }
  }
}

template <int MT>
__device__ __forceinline__ void outproj_tile(const Params& p, int layer, int tile, unsigned char* smem) {
  const int xcd = tile & 7, slot = tile >> 3;
  const int pm = xcd * 8 + (slot >> 3), pn = slot & 7;
  const int m0 = pm * (MT * 32), n0 = pn * 128;
  f32x4 acc[MT][4];
  gemm_tile<MT, true>(reinterpret_cast<const u16*>(p.ws + OFF_HZ), reinterpret_cast<const u16*>(p.ws + OFF_WOUT) + (size_t)layer * 1024 * 1024, 1024, m0, n0,
                      reinterpret_cast<u16*>(smem), acc);
  const int tid = tid_opaque(), lane = tid & 63, w = __builtin_amdgcn_readfirstlane(tid >> 6), wm = w >> 1, wn = w & 1, fr = lane & 15, fq = lane >> 4;
  const float* mods = reinterpret_cast<const float*>(p.ws + OFF_MODS) + (size_t)layer * 9 * 3072 + 2048;
  const float* xsrc = (layer == 0) ? p.x : p.out;
  float* ctxn = reinterpret_cast<float*>(p.ws + OFF_CTXN);
#pragma unroll
  for (int mi = 0; mi < MT; ++mi) {
    const int row = m0 + wm * (MT * 16) + mi * 16 + fr;
    const bool isx = row < MX;
    const int bidx = isx ? (row >> 11) : 8;
    const float* src = isx ? (xsrc + (size_t)row * DM) : (p.ctx + (size_t)(row - MX) * DM);
    float* dst = isx ? (p.out + (size_t)row * DM) : (ctxn + (size_t)(row - MX) * DM);
    const float* gate = mods + bidx * 3072;
#pragma unroll
    for (int ni = 0; ni < 4; ++ni) {
      const int col = n0 + wn * 64 + ni * 16 + fq * 4;
      const float4 g = *reinterpret_cast<const float4*>(gate + col);
      const float4 xv = *reinterpret_cast<const float4*>(src + col);
      float4 ov;
      ov.x = xv.x + g.x * acc[mi][ni][0]; ov.y = xv.y + g.y * acc[mi][ni][1];
      ov.z = xv.z + g.z * acc[mi][ni][2]; ov.w = xv.w + g.w * acc[mi][ni][3];
      *reinterpret_cast<float4*>(dst + col) = ov;
    }
  }
}

__device__ __forceinline__ void load_qk_norm(const u16* __restrict__ U, int row0, int colbase, const float* __restrict__ gain, float mul, u16* dstlds) {
  const int tid = tid_opaque(), lr = tid >> 3, lc = tid & 7;
  float g[8];
#pragma unroll
  for (int i = 0; i < 8; ++i) g[i] = gain[lc * 8 + i] * mul;
#pragma unroll
  for (int i = 0; i < 2; ++i) {
    int r = lr + 32 * i;
    uint4 v = *reinterpret_cast<const uint4*>(U + (size_t)(row0 + r) * UW + colbase + lc * 8);
    float f[8];
    f[0] = lo16(v.x); f[1] = hi16(v.x); f[2] = lo16(v.y); f[3] = hi16(v.y);
    f[4] = lo16(v.z); f[5] = hi16(v.z); f[6] = lo16(v.w); f[7] = hi16(v.w);
    float ss = 0.f;
#pragma unroll
    for (int k = 0; k < 8; ++k) ss += f[k] * f[k];
    ss += __shfl_xor(ss, 1); ss += __shfl_xor(ss, 2); ss += __shfl_xor(ss, 4);
    float rstd = rsqrtf(ss * (1.0f / 64.0f) + EPS);
    uint4 o;
    o.x = pack2(f[0] * rstd * g[0], f[1] * rstd * g[1]);
    o.y = pack2(f[2] * rstd * g[2], f[3] * rstd * g[3]);
    o.z = pack2(f[4] * rstd * g[4], f[5] * rstd * g[5]);
    o.w = pack2(f[6] * rstd * g[6], f[7] * rstd * g[7]);
    *reinterpret_cast<uint4*>(dstlds + swz(r, lc)) = o;
  }
}

__device__ __forceinline__ void att_store_k(const uint4& v, u16* dst, const float* kg) {
  float f0 = lo16(v.x), f1 = hi16(v.x), f2 = lo16(v.y), f3 = hi16(v.y), f4 = lo16(v.z), f5 = hi16(v.z), f6 = lo16(v.w), f7 = hi16(v.w);
  float ss = f0 * f0 + f1 * f1 + f2 * f2 + f3 * f3 + f4 * f4 + f5 * f5 + f6 * f6 + f7 * f7;
  ss += __shfl_xor(ss, 1); ss += __shfl_xor(ss, 2); ss += __shfl_xor(ss, 4);
  float rstd = rsqrtf(ss * (1.0f / 64.0f) + EPS);
  float4 g0 = *reinterpret_cast<const float4*>(kg), g1 = *reinterpret_cast<const float4*>(kg + 4);
  uint4 ov;
  ov.x = pack2(f0 * rstd * g0.x, f1 * rstd * g0.y);
  ov.y = pack2(f2 * rstd * g0.z, f3 * rstd * g0.w);
  ov.z = pack2(f4 * rstd * g1.x, f5 * rstd * g1.y);
  ov.w = pack2(f6 * rstd * g1.z, f7 * rstd * g1.w);
  *reinterpret_cast<uint4*>(dst) = ov;
}

template <bool LOCAL>
__device__ __forceinline__ void attn_mtile2(const u16* sQw, const u16* sK, const u16* sVT, const float* sBias, const int mi0,
                                            const int fr, const int fq, const int dr, const float negC, f32x4 (&o)[4][4], float (&l)[4]) {
  constexpr int NKT = LOCAL ? 2 : 4;
  int nb[2];
#pragma unroll
  for (int t = 0; t < 2; ++t) { const int mi = mi0 + t; nb[t] = LOCAL ? ((mi == 0) ? 0 : (mi == 1) ? 8 : (mi == 2) ? 24 : 32) : 0; }
  bf16x8 qf[2][2], kf[2][NKT][2];
#pragma unroll
  for (int t = 0; t < 2; ++t) {
    qf[t][0] = ldfrag(sQw + swz((mi0 + t) * 16 + fr, fq));
    qf[t][1] = ldfrag(sQw + swz((mi0 + t) * 16 + fr, 4 + fq));
  }
#pragma unroll
  for (int t = 0; t < (LOCAL ? 2 : 1); ++t)
#pragma unroll
    for (int kt = 0; kt < NKT; ++kt) {
      kf[t][kt][0] = ldfrag(sK + swz(nb[t] + kt * 16 + fr, fq));
      kf[t][kt][1] = ldfrag(sK + swz(nb[t] + kt * 16 + fr, 4 + fq));
    }
  float bv[2][8];
  if (LOCAL) {
#pragma unroll
    for (int t = 0; t < 2; ++t) {
      const float* bl = sBias + dr * 31 + (fq * 4 - fr) + (15 + nb[t] - (mi0 + t) * 16);
#pragma unroll
      for (int kt = 0; kt < 2; ++kt)
#pragma unroll
        for (int j = 0; j < 4; ++j) bv[t][kt * 4 + j] = bl[kt * 16 + j];
    }
  }
  __builtin_amdgcn_sched_barrier(0);
  f32x4 st[2][NKT];
#pragma unroll
  for (int t = 0; t < 2; ++t)
#pragma unroll
    for (int kt = 0; kt < NKT; ++kt) {
      const int tk = LOCAL ? t : 0;
      const float ini = LOCAL ? 0.f : negC;
      st[t][kt] = mfma16(kf[tk][kt][0], qf[t][0], f32x4{ini, ini, ini, ini});
      st[t][kt] = mfma16(kf[tk][kt][1], qf[t][1], st[t][kt]);
    }
  uint2 vlo[2][NKT / 2][4], vhi[2][NKT / 2][4];
#pragma unroll
  for (int t = 0; t < (LOCAL ? 2 : 1); ++t)
#pragma unroll
    for (int a = 0; a < NKT / 2; ++a)
#pragma unroll
      for (int dt = 0; dt < 4; ++dt) {
        const int c0 = (nb[t] >> 3) + 4 * a + (fq >> 1);
        vlo[t][a][dt] = *reinterpret_cast<const uint2*>(sVT + swz(dt * 16 + fr, c0) + (fq & 1) * 4);
        vhi[t][a][dt] = *reinterpret_cast<const uint2*>(sVT + swz(dt * 16 + fr, c0 + 2) + (fq & 1) * 4);
      }
  if (LOCAL) {
#pragma unroll
    for (int t = 0; t < 2; ++t) {
      const int cq = (mi0 + t) * 16 + fr;
      const int cs = min(max(cq - 8, 0), 48);
      const int tt = nb[t] + fq * 4 - cs;
#pragma unroll
      for (int kt = 0; kt < 2; ++kt)
#pragma unroll
        for (int j = 0; j < 4; ++j) {
          const bool ok = (unsigned)(tt + kt * 16 + j) < 16u;
          st[t][kt][j] = ok ? (st[t][kt][j] + bv[t][kt * 4 + j]) : -1e30f;
        }
    }
  }
#pragma unroll
  for (int t = 0; t < 2; ++t) {
    float ps = 0.f;
#pragma unroll
    for (int kt = 0; kt < NKT; ++kt)
#pragma unroll
      for (int j = 0; j < 4; ++j) { const float pv = __builtin_amdgcn_exp2f(st[t][kt][j]); st[t][kt][j] = pv; ps += pv; }
    l[mi0 + t] += ps;
  }
#pragma unroll
  for (int t = 0; t < 2; ++t)
#pragma unroll
    for (int a = 0; a < NKT / 2; ++a) {
      uint4 pk;
      pk.x = pack2(st[t][2 * a][0], st[t][2 * a][1]); pk.y = pack2(st[t][2 * a][2], st[t][2 * a][3]);
      pk.z = pack2(st[t][2 * a + 1][0], st[t][2 * a + 1][1]); pk.w = pack2(st[t][2 * a + 1][2], st[t][2 * a + 1][3]);
      const bf16x8 pf = *reinterpret_cast<bf16x8*>(&pk);
      const int tv = LOCAL ? t : 0;
#pragma unroll
      for (int dt = 0; dt < 4; ++dt) {
        uint4 vv; vv.x = vlo[tv][a][dt].x; vv.y = vlo[tv][a][dt].y; vv.z = vhi[tv][a][dt].x; vv.w = vhi[tv][a][dt].y;
        o[mi0 + t][dt] = mfma16(*reinterpret_cast<bf16x8*>(&vv), pf, o[mi0 + t][dt]);
      }
    }
  __builtin_amdgcn_sched_barrier(0);
}

__device__ __forceinline__ void attn_item(const Params& p, int layer, int item, unsigned char* smem) {
  u16* sKV = reinterpret_cast<u16*>(smem);
  u16* sP = sKV + 16384;
  float* sBias = reinterpret_cast<float*>(smem + 40960);
  float* sKg = sBias + 468;
  u16* sQ = reinterpret_cast<u16*>(smem + 43520);
  const int tid = tid_opaque(), lane = tid & 63, w = __builtin_amdgcn_readfirstlane(tid >> 6), fr = lane & 15, fq = lane >> 4;
  const u16* U = reinterpret_cast<const u16*>(p.ws + OFF_U);
  const u16* UT = reinterpret_cast<const u16*>(p.ws + OFF_UT);
  const bool lat = item < 512;
  int b, h, qrow0, r = 0, R0 = 0, kr_lo = 0, nlocal = 0;
  if (lat) {
    b = item >> 6; h = (item >> 3) & 7; const int g = item & 7;
    r = g * 4 + w; R0 = min(max(r - 4, 0), 24);
    kr_lo = min(max(g * 4 - 4, 0), 24);
    const int kr_hi = min(max(g * 4 + 3 - 4, 0), 24) + 7;
    nlocal = kr_hi - kr_lo + 1;
    qrow0 = b * SEQ + g * 256;
  } else {
    const int it = item - 512; b = it >> 3; h = it & 7; qrow0 = MX + b * LC;
  }
  const float negC = -reinterpret_cast<const float*>(p.ws + OFF_SHIFT)[layer * 2 + (lat ? 1 : 0)];
  if (lat) {
    const float* rp = p.rpb + ((size_t)layer * 8 + h) * 465;
    for (int i = tid; i < 465; i += 256) sBias[i] = rp[i] * 1.4426950408889634f + negC;
  }
  if (tid < 64) sKg[tid] = p.kg[layer * 64 + tid];
#pragma unroll 1
  for (int qq = 0; qq < 4; ++qq) load_qk_norm(U, qrow0 + qq * 64, h * 64, p.qg + layer * 64, 0.125f * 1.4426950408889634f, sQ + qq * 4096);
  __syncthreads();
  f32x4 o[4][4];
  float l[4];
#pragma unroll
  for (int mi = 0; mi < 4; ++mi) {
    l[mi] = 0.f;
#pragma unroll
    for (int j = 0; j < 4; ++j) o[mi][j] = f32x4{0.f, 0.f, 0.f, 0.f};
  }
  u16* sPw = sP + w * 1024;
  const int nch = nlocal + 4;
  const int lr = tid >> 3, lc = tid & 7;
  const int vd = tid >> 2, vpart = tid & 3;
  uint4 rk0, rk1, rv0, rv1;
#define ATT_ISSUE(CH) do { const int ch_ = (CH); \
    const int krow0_ = (ch_ < nlocal) ? (b * SEQ + (kr_lo + ch_) * 64) : (MX + b * LC + (ch_ - nlocal) * 64); \
    rk0 = *reinterpret_cast<const uint4*>(U + (size_t)(krow0_ + lr) * UW + 512 + h * 64 + lc * 8); \
    rk1 = *reinterpret_cast<const uint4*>(U + (size_t)(krow0_ + lr + 32) * UW + 512 + h * 64 + lc * 8); \
    rv0 = *reinterpret_cast<const uint4*>(UT + (size_t)(h * 64 + vd) * MALL + krow0_ + (vpart * 2) * 8); \
    rv1 = *reinterpret_cast<const uint4*>(UT + (size_t)(h * 64 + vd) * MALL + krow0_ + (vpart * 2 + 1) * 8); } while (0)
#define ATT_STORE(BUF) do { u16* dK_ = sKV + (BUF) * 4096; u16* dV_ = sKV + 8192 + (BUF) * 4096; \
    att_store_k(rk0, dK_ + swz(lr, lc), sKg + lc * 8); att_store_k(rk1, dK_ + swz(lr + 32, lc), sKg + lc * 8); \
    *reinterpret_cast<uint4*>(dV_ + swz(vd, vpart * 2)) = rv0; *reinterpret_cast<uint4*>(dV_ + swz(vd, vpart * 2 + 1)) = rv1; } while (0)
  ATT_ISSUE(0);
  ATT_STORE(0);
  __syncthreads();
#pragma unroll 1
  for (int ch = 0; ch < nch; ++ch) {
    const bool more = (ch + 1) < nch;
    if (more) ATT_ISSUE(ch + 1);
    __builtin_amdgcn_sched_barrier(0);
    const bool local = ch < nlocal;
    const int kr = kr_lo + ch;
    const bool active = !local || (kr >= R0 && kr <= R0 + 7);
    const u16* sK = sKV + (ch & 1) * 4096;
    const u16* sVT = sKV + 8192 + (ch & 1) * 4096;
    if (active) {
      int frl = fr, fql = fq;
      asm volatile("" : "+v"(frl), "+v"(fql));
      if (local) {
        const int dr = kr - r + 7;
        attn_mtile2<true>(sQ + w * 4096, sK, sVT, sBias, 0, frl, fql, dr, negC, o, l);
        attn_mtile2<true>(sQ + w * 4096, sK, sVT, sBias, 2, frl, fql, dr, negC, o, l);
      } else {
        attn_mtile2<false>(sQ + w * 4096, sK, sVT, sBias, 0, frl, fql, 0, negC, o, l);
        attn_mtile2<false>(sQ + w * 4096, sK, sVT, sBias, 2, frl, fql, 0, negC, o, l);
      }
    }
    __builtin_amdgcn_sched_barrier(0);
    if (more) ATT_STORE((ch + 1) & 1);
    __syncthreads();
  }
  u16* Z = reinterpret_cast<u16*>(p.ws + OFF_HZ);
#pragma unroll
  for (int mi = 0; mi < 4; ++mi) {
    int fre = fr, fqe = fq;
    asm volatile("" : "+v"(fre), "+v"(fqe) :: "memory");
    float lt = l[mi];
    lt += __shfl_xor(lt, 16);
    lt += __shfl_xor(lt, 32);
    const float inv = 1.0f / lt;
    const int row = qrow0 + w * 64 + mi * 16 + fre;
    typedef unsigned u2a_t __attribute__((ext_vector_type(2)));
    const int coff = (fqe & 1) ? (16 + (fqe - 1) * 4) : (fqe * 4);
    uint2 ovv[4];
#pragma unroll
    for (int dt = 0; dt < 4; ++dt) {
      const int dcol = h * 64 + dt * 16 + fqe * 4;
      uint2 gv = *reinterpret_cast<const uint2*>(U + (size_t)row * UW + 1024 + dcol);
      ovv[dt].x = pack2(o[mi][dt][0] * inv * silu(lo16(gv.x)), o[mi][dt][1] * inv * silu(hi16(gv.x)));
      ovv[dt].y = pack2(o[mi][dt][2] * inv * silu(lo16(gv.y)), o[mi][dt][3] * inv * silu(hi16(gv.y)));
    }
#pragma unroll
    for (int a = 0; a < 2; ++a) {
      const u2a_t sx = __builtin_amdgcn_permlane16_swap(ovv[2 * a].x, ovv[2 * a + 1].x, false, false);
      const u2a_t sy = __builtin_amdgcn_permlane16_swap(ovv[2 * a].y, ovv[2 * a + 1].y, false, false);
      uint4 o4; o4.x = sx.x; o4.y = sy.x; o4.z = sx.y; o4.w = sy.y;
      *reinterpret_cast<uint4*>(Z + (size_t)row * DM + h * 64 + a * 32 + coff) = o4;
    }
  }
  asm volatile("" ::: "memory");
  __syncthreads();
}

template <typename F>
__device__ __forceinline__ void ret_load_rope(const u16* __restrict__ U, int rowbase, int colbase, bool rope, int tpos0, float mul, F&& sink) {
  const int tid = tid_opaque();
#pragma unroll
  for (int i = 0; i < 2; ++i) {
    int id = tid + 256 * i;
    int l = id >> 2, pr = id & 3;
    int c = (pr & 1) + ((pr >> 1) << 2);
    const u16* src = U + (size_t)(rowbase + l) * UW + colbase + c * 8;
    uint4 v1 = *reinterpret_cast<const uint4*>(src);
    uint4 v2 = *reinterpret_cast<const uint4*>(src + 16);
    float x1[8], x2[8];
    x1[0] = lo16(v1.x); x1[1] = hi16(v1.x); x1[2] = lo16(v1.y); x1[3] = hi16(v1.y);
    x1[4] = lo16(v1.z); x1[5] = hi16(v1.z); x1[6] = lo16(v1.w); x1[7] = hi16(v1.w);
    x2[0] = lo16(v2.x); x2[1] = hi16(v2.x); x2[2] = lo16(v2.y); x2[3] = hi16(v2.y);
    x2[4] = lo16(v2.z); x2[5] = hi16(v2.z); x2[6] = lo16(v2.w); x2[7] = hi16(v2.w);
    float o1[8], o2[8];
    if (rope) {
      int t = tpos0 + l;
      float pos = (float)((c >= 4) ? (t & 63) : (t >> 6));
#pragma unroll
      for (int k = 0; k < 8; ++k) {
        int fi = (c & 1) * 8 + k;
        float freq = exp2f(-(float)fi * (13.287712379549449f / 16.0f));
        float ang = pos * freq;
        float sn, cs; sincos_rr(ang, sn, cs);
        o1[k] = (x1[k] * cs - x2[k] * sn) * mul;
        o2[k] = (x1[k] * sn + x2[k] * cs) * mul;
      }
    } else {
#pragma unroll
      for (int k = 0; k < 8; ++k) { o1[k] = x1[k] * mul; o2[k] = x2[k] * mul; }
    }
    sink(l, c, o1, o2);
  }
}

__device__ __forceinline__ void ret_load_vt(const u16* __restrict__ UT, int h, int rowbase, u16* sVT) {
  const int tid = tid_opaque();
  int e = tid >> 2, part = tid & 3;
#pragma unroll
  for (int i = 0; i < 4; ++i) {
    int kg = part * 4 + i;
    uint4 v = *reinterpret_cast<const uint4*>(UT + (size_t)(1536 + h * 64 + e) * MALL + rowbase + kg * 8);
    *reinterpret_cast<uint4*>(sVT + (kg >> 3) * 4096 + swz(e, kg & 7)) = v;
  }
}

__device__ __forceinline__ void retkv_item(const Params& p, int layer, int item, unsigned char* smem) {
  u16* sVT = reinterpret_cast<u16*>(smem);
  u16* sKf = sVT + 8192;
  u16* sKb = sVT + 16384;
  const int tid = tid_opaque(), lane = tid & 63, w = __builtin_amdgcn_readfirstlane(tid >> 6), fr = lane & 15, fq = lane >> 4;
  const int ci = item % 18, bh = item / 18, h = bh & 3, b = bh >> 2;
  const bool lat = ci < 16;
  const int rowbase = lat ? (b * SEQ + ci * 128) : (MX + b * LC + (ci - 16) * 128);
  const float lgf = -__expf(p.rlr[layer * 8 + h]), lgb = -__expf(p.rlr[layer * 8 + 4 + h]);
  const u16* U = reinterpret_cast<const u16*>(p.ws + OFF_U);
  const u16* UT = reinterpret_cast<const u16*>(p.ws + OFF_UT);
  ret_load_vt(UT, h, rowbase, sVT);
  ret_load_rope(U, rowbase, 1792 + h * 64, lat, ci * 128, 0.125f, [&](int l, int c, float* o1, float* o2) {
    float wf = __expf(lgf * (float)(127 - l)), wb = __expf(lgb * (float)l);
    int pan = (l >> 6) * 4096, kc = (l & 63) >> 3, e7 = l & 7;
#pragma unroll
    for (int k = 0; k < 8; ++k) {
      int d1 = c * 8 + k, d2 = d1 + 16;
      sKf[pan + swz(d1, kc) + e7] = f2bf(o1[k] * wf);
      sKf[pan + swz(d2, kc) + e7] = f2bf(o2[k] * wf);
      sKb[pan + swz(d1, kc) + e7] = f2bf(o1[k] * wb);
      sKb[pan + swz(d2, kc) + e7] = f2bf(o2[k] * wb);
    }
  });
  __syncthreads();
  f32x4 acc[2][4];
#pragma unroll
  for (int d = 0; d < 2; ++d)
#pragma unroll
    for (int ni = 0; ni < 4; ++ni) acc[d][ni] = f32x4{0.f, 0.f, 0.f, 0.f};
#pragma unroll
  for (int ks = 0; ks < 4; ++ks) {
    int pan = (ks >> 1) * 4096, kc = (ks & 1) * 4 + fq;
    bf16x8 a = ldfrag(sVT + pan + swz(w * 16 + fr, kc));
#pragma unroll
    for (int ni = 0; ni < 4; ++ni) {
      bf16x8 bf_ = ldfrag(sKf + pan + swz(ni * 16 + fr, kc));
      bf16x8 bb_ = ldfrag(sKb + pan + swz(ni * 16 + fr, kc));
      acc[0][ni] = mfma16(a, bf_, acc[0][ni]);
      acc[1][ni] = mfma16(a, bb_, acc[1][ni]);
    }
  }
  float* dst = reinterpret_cast<float*>(p.ws + OFF_RKV) + (size_t)item * 2 * 4096;
#pragma unroll
  for (int d = 0; d < 2; ++d)
#pragma unroll
    for (int ni = 0; ni < 4; ++ni)
#pragma unroll
      for (int j = 0; j < 4; ++j) dst[d * 4096 + (w * 16 + fq * 4 + j) * 64 + ni * 16 + fr] = acc[d][ni][j];
  __syncthreads();
}

__device__ __forceinline__ void retout_item(const Params& p, int layer, int item, unsigned char* smem) {
  u16* sQ = reinterpret_cast<u16*>(smem);
  u16* sK = sQ + 8192;
  u16* sVT = sQ + 16384;
  u16* sPf = sQ + 24576;
  u16* sPb = sQ + 28672;
  u16* sP = sQ;
  const int tid = tid_opaque(), lane = tid & 63, w = __builtin_amdgcn_readfirstlane(tid >> 6), fr = lane & 15, fq = lane >> 4;
  const int ci = item % 18, bh = item / 18, h = bh & 3, b = bh >> 2;
  const bool lat = ci < 16;
  const int rowbase = lat ? (b * SEQ + ci * 128) : (MX + b * LC + (ci - 16) * 128);
  const float lgf = -__expf(p.rlr[layer * 8 + h]), lgb = -__expf(p.rlr[layer * 8 + 4 + h]);
  const u16* U = reinterpret_cast<const u16*>(p.ws + OFF_U);
  const u16* UT = reinterpret_cast<const u16*>(p.ws + OFF_UT);
  ret_load_vt(UT, h, rowbase, sVT);
  ret_load_rope(U, rowbase, 1536 + h * 64, lat, ci * 128, 1.0f, [&](int l, int c, float* o1, float* o2) {
    uint4 a, bq;
    a.x = pack2(o1[0], o1[1]); a.y = pack2(o1[2], o1[3]); a.z = pack2(o1[4], o1[5]); a.w = pack2(o1[6], o1[7]);
    bq.x = pack2(o2[0], o2[1]); bq.y = pack2(o2[2], o2[3]); bq.z = pack2(o2[4], o2[5]); bq.w = pack2(o2[6], o2[7]);
    *reinterpret_cast<uint4*>(sQ + swz(l, c)) = a;
    *reinterpret_cast<uint4*>(sQ + swz(l, c + 2)) = bq;
  });
  ret_load_rope(U, rowbase, 1792 + h * 64, lat, ci * 128, 0.125f, [&](int l, int c, float* o1, float* o2) {
    uint4 a, bq;
    a.x = pack2(o1[0], o1[1]); a.y = pack2(o1[2], o1[3]); a.z = pack2(o1[4], o1[5]); a.w = pack2(o1[6], o1[7]);
    bq.x = pack2(o2[0], o2[1]); bq.y = pack2(o2[2], o2[3]); bq.z = pack2(o2[4], o2[5]); bq.w = pack2(o2[6], o2[7]);
    *reinterpret_cast<uint4*>(sK + swz(l, c)) = a;
    *reinterpret_cast<uint4*>(sK + swz(l, c + 2)) = bq;
  });
  {
    const float* kvb = reinterpret_cast<const float*>(p.ws + OFF_RKV) + (size_t)bh * 18 * 2 * 4096;
    const int e = tid >> 2, d0 = (tid & 3) * 16;
    float af[16], ab[16];
#pragma unroll
    for (int i = 0; i < 16; ++i) { af[i] = 0.f; ab[i] = 0.f; }
    const int nsrc = lat ? 19 : 1;
#pragma unroll 1
    for (int kb = 0; kb < nsrc; kb += 4) {
      float4 v[4][4];
      float wgt[4];
      int dirs[4];
#pragma unroll
      for (int u = 0; u < 4; ++u) {
        const int k = kb + u;
        int m = 0, dir = 0; float wv = 0.f;
        if (lat) {
          if (k < ci) { m = k; dir = 0; wv = __expf(lgf * 128.f * (float)(ci - 1 - k)); }
          else if (k == ci) { m = 16; dir = 0; wv = __expf(lgf * 128.f * (float)(ci + 1)); }
          else if (k == ci + 1) { m = 17; dir = 0; wv = __expf(lgf * 128.f * (float)ci); }
          else if (k < 19) {
            const int q = k - (ci + 2);
            dir = 1;
            if (q < 15 - ci) { m = ci + 1 + q; wv = __expf(lgb * 128.f * (float)q); }
            else if (q == 15 - ci) { m = 16; wv = __expf(lgb * 128.f * (float)(15 - ci)); }
            else { m = 17; wv = __expf(lgb * 128.f * (float)(16 - ci)); }
          }
        } else if (k == 0) {
          if (ci == 16) { m = 17; dir = 1; wv = 1.f; } else { m = 16; dir = 0; wv = 1.f; }
        }
        wgt[u] = wv; dirs[u] = dir;
        const float* sp = kvb + ((size_t)m * 2 + dir) * 4096 + e * 64 + d0;
#pragma unroll
        for (int i = 0; i < 4; ++i) v[u][i] = *reinterpret_cast<const float4*>(sp + i * 4);
      }
      __builtin_amdgcn_sched_barrier(0);
#pragma unroll
      for (int u = 0; u < 4; ++u) {
        const float wf = dirs[u] == 0 ? wgt[u] : 0.f, wb = dirs[u] == 0 ? 0.f : wgt[u];
#pragma unroll
        for (int i = 0; i < 4; ++i) {
          af[i * 4 + 0] += wf * v[u][i].x; af[i * 4 + 1] += wf * v[u][i].y; af[i * 4 + 2] += wf * v[u][i].z; af[i * 4 + 3] += wf * v[u][i].w;
          ab[i * 4 + 0] += wb * v[u][i].x; ab[i * 4 + 1] += wb * v[u][i].y; ab[i * 4 + 2] += wb * v[u][i].z; ab[i * 4 + 3] += wb * v[u][i].w;
        }
      }
    }
#pragma unroll
    for (int hf = 0; hf < 2; ++hf) {
      uint4 a, bq;
      a.x = pack2(af[hf * 8 + 0], af[hf * 8 + 1]); a.y = pack2(af[hf * 8 + 2], af[hf * 8 + 3]); a.z = pack2(af[hf * 8 + 4], af[hf * 8 + 5]); a.w = pack2(af[hf * 8 + 6], af[hf * 8 + 7]);
      bq.x = pack2(ab[hf * 8 + 0], ab[hf * 8 + 1]); bq.y = pack2(ab[hf * 8 + 2], ab[hf * 8 + 3]); bq.z = pack2(ab[hf * 8 + 4], ab[hf * 8 + 5]); bq.w = pack2(ab[hf * 8 + 6], ab[hf * 8 + 7]);
      *reinterpret_cast<uint4*>(sPf + swz(e, (d0 >> 3) + hf)) = a;
      *reinterpret_cast<uint4*>(sPb + swz(e, (d0 >> 3) + hf)) = bq;
    }
  }
  __syncthreads();
  f32x4 S[2][8], Of[2][4], Ob[2][4];
#pragma unroll
  for (int mi = 0; mi < 2; ++mi) {
#pragma unroll
    for (int ni = 0; ni < 8; ++ni) S[mi][ni] = f32x4{0.f, 0.f, 0.f, 0.f};
#pragma unroll
    for (int ni = 0; ni < 4; ++ni) { Of[mi][ni] = f32x4{0.f, 0.f, 0.f, 0.f}; Ob[mi][ni] = f32x4{0.f, 0.f, 0.f, 0.f}; }
  }
#pragma unroll
  for (int ks = 0; ks < 2; ++ks) {
    bf16x8 qa[2];
#pragma unroll
    for (int mi = 0; mi < 2; ++mi) qa[mi] = ldfrag(sQ + swz(w * 32 + mi * 16 + fr, ks * 4 + fq));
#pragma unroll
    for (int ni = 0; ni < 8; ++ni) {
      bf16x8 kf = ldfrag(sK + swz(ni * 16 + fr, ks * 4 + fq));
#pragma unroll
      for (int mi = 0; mi < 2; ++mi) S[mi][ni] = mfma16(qa[mi], kf, S[mi][ni]);
    }
#pragma unroll
    for (int ni = 0; ni < 4; ++ni) {
      bf16x8 pf = ldfrag(sPf + swz(ni * 16 + fr, ks * 4 + fq));
      bf16x8 pb = ldfrag(sPb + swz(ni * 16 + fr, ks * 4 + fq));
#pragma unroll
      for (int mi = 0; mi < 2; ++mi) { Of[mi][ni] = mfma16(pf, qa[mi], Of[mi][ni]); Ob[mi][ni] = mfma16(pb, qa[mi], Ob[mi][ni]); }
    }
  }
  __syncthreads();
#pragma unroll
  for (int mi = 0; mi < 2; ++mi)
#pragma unroll
    for (int ni = 0; ni < 8; ++ni) {
      int lcol = ni * 16 + fr;
#pragma unroll
      for (int j = 0; j < 4; ++j) {
        int jrow = w * 32 + mi * 16 + fq * 4 + j;
        int diff = jrow - lcol;
        float dd = 0.f;
        if (diff >= 0) dd += __expf(lgf * (float)diff);
        if (diff <= 0) dd += __expf(lgb * (float)(-diff));
        sP[(lcol >> 6) * 8192 + swz(jrow, (lcol & 63) >> 3) + (lcol & 7)] = f2bf(S[mi][ni][j] * dd);
      }
    }
  __syncthreads();
  f32x4 O[2][4];
#pragma unroll
  for (int mi = 0; mi < 2; ++mi)
#pragma unroll
    for (int ni = 0; ni < 4; ++ni) O[mi][ni] = f32x4{0.f, 0.f, 0.f, 0.f};
#pragma unroll
  for (int ks = 0; ks < 4; ++ks) {
    int kc = (ks & 1) * 4 + fq;
    bf16x8 pa[2];
#pragma unroll
    for (int mi = 0; mi < 2; ++mi) pa[mi] = ldfrag(sP + (ks >> 1) * 8192 + swz(w * 32 + mi * 16 + fr, kc));
#pragma unroll
    for (int ni = 0; ni < 4; ++ni) {
      bf16x8 vf = ldfrag(sVT + (ks >> 1) * 4096 + swz(ni * 16 + fr, kc));
#pragma unroll
      for (int mi = 0; mi < 2; ++mi) O[mi][ni] = mfma16(vf, pa[mi], O[mi][ni]);
    }
  }
  u16* Z = reinterpret_cast<u16*>(p.ws + OFF_HZ);
#pragma unroll
  for (int mi = 0; mi < 2; ++mi) {
    const int jrow = w * 32 + mi * 16 + fr;
    const float xf = __expf(lgf * (float)(jrow + 1)), xb = __expf(lgb * (float)(128 - jrow));
    float v[4][4], ss = 0.f;
#pragma unroll
    for (int ni = 0; ni < 4; ++ni)
#pragma unroll
      for (int j = 0; j < 4; ++j) { v[ni][j] = O[mi][ni][j] + xf * Of[mi][ni][j] + xb * Ob[mi][ni][j]; ss += v[ni][j] * v[ni][j]; }
    ss += __shfl_xor(ss, 16);
    ss += __shfl_xor(ss, 32);
    const float rstd = rsqrtf(ss * (1.0f / 64.0f) + EPS);
    const int row = rowbase + jrow;
    typedef unsigned u2r_t __attribute__((ext_vector_type(2)));
    const int coff = (fq & 1) ? (16 + (fq - 1) * 4) : (fq * 4);
    uint2 ovv[4];
#pragma unroll
    for (int ni = 0; ni < 4; ++ni) {
      const int e = ni * 16 + fq * 4;
      const uint2 gv = *reinterpret_cast<const uint2*>(U + (size_t)row * UW + 2048 + h * 64 + e);
      ovv[ni].x = pack2(v[ni][0] * rstd * silu(lo16(gv.x)), v[ni][1] * rstd * silu(hi16(gv.x)));
      ovv[ni].y = pack2(v[ni][2] * rstd * silu(lo16(gv.y)), v[ni][3] * rstd * silu(hi16(gv.y)));
    }
#pragma unroll
    for (int a = 0; a < 2; ++a) {
      const u2r_t sx = __builtin_amdgcn_permlane16_swap(ovv[2 * a].x, ovv[2 * a + 1].x, false, false);
      const u2r_t sy = __builtin_amdgcn_permlane16_swap(ovv[2 * a].y, ovv[2 * a + 1].y, false, false);
      uint4 o4; o4.x = sx.x; o4.y = sy.x; o4.z = sx.y; o4.w = sy.y;
      *reinterpret_cast<uint4*>(Z + (size_t)row * DM + 768 + h * 64 + a * 32 + coff) = o4;
    }
  }
  __syncthreads();
}

__device__ __forceinline__ float block_sum(float v, float* red) {
#pragma unroll
  for (int o = 1; o < 64; o <<= 1) v += __shfl_xor(v, o);
  __syncthreads();
  if ((threadIdx.x & 63) == 0) red[threadIdx.x >> 6] = v;
  __syncthreads();
  return red[0] + red[1] + red[2] + red[3];
}

struct HyRaw { uint4 v; u16 e0, e1; };
template <int LX>
__device__ __forceinline__ HyRaw hy_load8(const u16* __restrict__ s, int tc) {
  HyRaw r;
  r.v = *reinterpret_cast<const uint4*>(s);
  r.e0 = (tc > 0) ? s[-1] : (u16)0;
  r.e1 = (tc < LX / 8 - 1) ? s[8] : (u16)0;
  return r;
}
__device__ __forceinline__ void hy_eval8(const HyRaw& r, float w0, float w1, float w2, float bb, float* o) {
  float f[10];
  f[0] = bf2f(r.e0);
  f[1] = lo16(r.v.x); f[2] = hi16(r.v.x); f[3] = lo16(r.v.y); f[4] = hi16(r.v.y);
  f[5] = lo16(r.v.z); f[6] = hi16(r.v.z); f[7] = lo16(r.v.w); f[8] = hi16(r.v.w);
  f[9] = bf2f(r.e1);
#pragma unroll
  for (int i = 0; i < 8; ++i) o[i] = w0 * f[i] + w1 * f[i + 1] + w2 * f[i + 2] + bb;
}

template <int LX, int NT>
__device__ __forceinline__ void hyena_item(const Params& p, int layer, int c, unsigned char* smem) {
  constexpr int T1 = LX / 32;
  constexpr int RSTR = 2 * LX + 32;
  u16* sU = reinterpret_cast<u16*>(smem);
  u16* sR = sU + 16384 + 256;
  float* red = reinterpret_cast<float*>(smem + 32768 + 512 + 4 * (2 * SEQ + 32) * 2);
  const int tid = tid_opaque(), lane = tid & 63, w = __builtin_amdgcn_readfirstlane(tid >> 6), fr = lane & 15, fq = lane >> 4;
  const int rowbase = (LX == SEQ) ? 0 : MX;
  const u16* UT = reinterpret_cast<const u16*>(p.ws + OFF_UT);
  const float* filt = (LX == SEQ) ? (reinterpret_cast<const float*>(p.ws + OFF_FILT) + (size_t)layer * 1024 * SEQ) : reinterpret_cast<const float*>(p.ws + OFF_FILTC);
  const float* cw = p.cw + layer * 3 * 768;
  const float* cb = p.cb + layer * 768;
  u16* Z = reinterpret_cast<u16*>(p.ws + OFF_HZ);
  constexpr int NTAP = (2 * LX - 1 + 255) / 256;
  float taps[NTAP];
  {
    const float* ff = filt + (size_t)(0 * 256 + c) * LX;
    const float* fb = filt + (size_t)(1 * 256 + c) * LX;
#pragma unroll
    for (int i = 0; i < NTAP; ++i) {
      const int y = tid + 256 * i;
      taps[i] = (y < LX) ? ff[LX - 1 - y] : ((y < 2 * LX - 1) ? fb[y - (LX - 1)] : 0.f);
    }
  }
  if (tid < 32) { unsigned zz; asm volatile("v_mov_b32 %0, 0" : "=v"(zz)); *reinterpret_cast<uint4*>(sU + (T1 * 4 * 8) * 8 + tid * 8) = uint4{zz, zz, zz, zz}; }
  {
    const float w0 = cw[c], w1 = cw[768 + c], w2 = cw[1536 + c], bb = cb[c];
    const u16* src = UT + (size_t)(512 + c) * MALL + rowbase;
    constexpr int NIT = LX / 256;
    constexpr int NBT = (NIT < 4) ? NIT : 4;
#pragma unroll 1
    for (int it0 = 0; it0 < NIT; it0 += NBT) {
      HyRaw raw[NBT];
#pragma unroll
      for (int it = 0; it < NBT; ++it) { const int id = tid + 256 * (it0 + it); const int b = id / (LX / 8), tc = id % (LX / 8); raw[it] = hy_load8<LX>(src + b * LX + tc * 8, tc); }
      __builtin_amdgcn_sched_barrier(0);
#pragma unroll
      for (int it = 0; it < NBT; ++it) {
        const int id = tid + 256 * (it0 + it); const int b = id / (LX / 8), tc = id % (LX / 8);
        float o[8];
        hy_eval8(raw[it], w0, w1, w2, bb, o);
        uint4 ov; ov.x = pack2(o[0], o[1]); ov.y = pack2(o[2], o[3]); ov.z = pack2(o[4], o[5]); ov.w = pack2(o[6], o[7]);
        *reinterpret_cast<uint4*>(sU + (tc * 8 + b) * 8) = ov;
      }
    }
  }
  const int t1lo = w * NT * 2;
#pragma unroll 1
  for (int ord = 0; ord < 2; ++ord) {
    {
      float sa = 0.f;
#pragma unroll
      for (int i = 0; i < NTAP; ++i) sa += fabsf(taps[i]);
      float tot = block_sum(sa, red);
      float inv = 1.0f / tot;
#pragma unroll
      for (int i = 0; i < NTAP; ++i) {
        const int y = tid + 256 * i;
        if (y < 2 * LX - 1) {
          u16 hv = f2bf(taps[i] * inv);
          sR[y] = hv;
          if (y >= 1) sR[RSTR + y - 1] = hv;
          if (y >= 2) sR[2 * RSTR + y - 2] = hv;
          if (y >= 3) sR[3 * RSTR + y - 3] = hv;
        }
      }
    }
    __syncthreads();
    if (ord == 0) {
      const float* ff = filt + (size_t)(2 * 256 + c) * LX;
      const float* fb = filt + (size_t)(3 * 256 + c) * LX;
#pragma unroll
      for (int i = 0; i < NTAP; ++i) {
        const int y = tid + 256 * i;
        taps[i] = (y < LX) ? ff[LX - 1 - y] : ((y < 2 * LX - 1) ? fb[y - (LX - 1)] : 0.f);
      }
    }
    f32x4 acc[2][NT];
#pragma unroll
    for (int mi = 0; mi < 2; ++mi)
#pragma unroll
      for (int ni = 0; ni < NT; ++ni) acc[mi][ni] = f32x4{0.f, 0.f, 0.f, 0.f};
    const int d1lo = t1lo - (T1 - 1), d1hi = t1lo + NT * 2 - 1;
    bf16x8 a0[2], b0[NT], a1[2], b1[NT];
    int ubase[NT];
#pragma unroll
    for (int ni = 0; ni < NT; ++ni) ubase[ni] = (w * NT + ni) * 16 + fr;
#define HY_LOAD(D1, AF, BF) do { const int d1_ = (D1); \
      _Pragma("unroll") for (int mi = 0; mi < 2; ++mi) { \
        int y0 = (LX - 1) - (32 * d1_ + mi * 16 + fr - fq * 8); int sh = y0 & 3; \
        const u16* q = sR + sh * RSTR + (y0 - sh); \
        uint2 lo = *reinterpret_cast<const uint2*>(q); uint2 hi = *reinterpret_cast<const uint2*>(q + 4); \
        uint4 pk; pk.x = lo.x; pk.y = lo.y; pk.z = hi.x; pk.w = hi.y; AF[mi] = *reinterpret_cast<bf16x8*>(&pk); } \
      _Pragma("unroll") for (int ni = 0; ni < NT; ++ni) { \
        int t1s = (ubase[ni] >> 3) - d1_; \
        t1s = ((unsigned)t1s < (unsigned)T1) ? t1s : T1; \
        BF[ni] = ldfrag(sU + ((4 * t1s + fq) * 8 + (ubase[ni] & 7)) * 8); } } while (0)
#define HY_MMA(AF, BF) do { \
      _Pragma("unroll") for (int ni = 0; ni < NT; ++ni) \
        _Pragma("unroll") for (int mi = 0; mi < 2; ++mi) acc[mi][ni] = mfma16(AF[mi], BF[ni], acc[mi][ni]); } while (0)
    HY_LOAD(d1lo, a0, b0);
#pragma unroll 1
    for (int d1 = d1lo; d1 <= d1hi; d1 += 2) {
      HY_LOAD(min(d1 + 1, d1hi), a1, b1);
      HY_MMA(a0, b0);
      HY_LOAD(min(d1 + 2, d1hi), a0, b0);
      if (d1 + 1 <= d1hi) HY_MMA(a1, b1);
    }
#undef HY_MMA
#undef HY_LOAD
    __syncthreads();
    {
      int fr_e = fr, fq_e = fq;
      asm volatile("" : "+v"(fr_e), "+v"(fq_e));
      const float skipv = p.skip[(layer * 2 + ord) * 256 + c];
#pragma unroll
      for (int ni = 0; ni < NT; ++ni) {
        int n = (w * NT + ni) * 16 + fr_e;
        int t1 = n >> 3, b = n & 7;
#pragma unroll
        for (int mi = 0; mi < 2; ++mi) {
          int t = 32 * t1 + mi * 16 + fq_e * 4;
          u16* up = sU + (((t >> 3) * 8 + b) * 8 + (t & 7));
          uint2 uv = *reinterpret_cast<const uint2*>(up);
          uint2 ov;
          ov.x = pack2(acc[mi][ni][0] + lo16(uv.x) * skipv, acc[mi][ni][1] + hi16(uv.x) * skipv);
          ov.y = pack2(acc[mi][ni][2] + lo16(uv.y) * skipv, acc[mi][ni][3] + hi16(uv.y) * skipv);
          *reinterpret_cast<uint2*>(up) = ov;
        }
      }
    }
    __syncthreads();
    {
      const int gch = (ord == 0) ? (768 + c) : (1024 + c);
      const int cwi = (ord == 0) ? (256 + c) : (512 + c);
      const float w0 = cw[cwi], w1 = cw[768 + cwi], w2 = cw[1536 + cwi], bb = cb[cwi];
      const u16* src = UT + (size_t)gch * MALL + rowbase;
      const u16* ghs = UT + (size_t)(1280 + c) * MALL + rowbase;
      constexpr int NIT = LX / 256;
      constexpr int NBT = (NIT < 4) ? NIT : 4;
#pragma unroll 1
      for (int it0 = 0; it0 < NIT; it0 += NBT) {
        HyRaw raw[NBT];
        uint4 ghv[NBT];
#pragma unroll
        for (int it = 0; it < NBT; ++it) {
          const int id = tid + 256 * (it0 + it); const int b = id / (LX / 8), tc = id % (LX / 8);
          raw[it] = hy_load8<LX>(src + b * LX + tc * 8, tc);
          ghv[it] = (ord == 1) ? *reinterpret_cast<const uint4*>(ghs + b * LX + tc * 8) : uint4{0u, 0u, 0u, 0u};
        }
        __builtin_amdgcn_sched_barrier(0);
#pragma unroll
        for (int it = 0; it < NBT; ++it) {
          const int id = tid + 256 * (it0 + it); const int b = id / (LX / 8), tc = id % (LX / 8);
          float g[8];
          hy_eval8(raw[it], w0, w1, w2, bb, g);
          u16* up = sU + (tc * 8 + b) * 8;
          uint4 uv = *reinterpret_cast<const uint4*>(up);
          float y[8] = {lo16(uv.x), hi16(uv.x), lo16(uv.y), hi16(uv.y), lo16(uv.z), hi16(uv.z), lo16(uv.w), hi16(uv.w)};
          if (ord == 0) {
            uint4 ov;
            ov.x = pack2(y[0] * g[0], y[1] * g[1]); ov.y = pack2(y[2] * g[2], y[3] * g[3]);
            ov.z = pack2(y[4] * g[4], y[5] * g[5]); ov.w = pack2(y[6] * g[6], y[7] * g[7]);
            *reinterpret_cast<uint4*>(up) = ov;
          } else {
            const uint4 hv = ghv[it];
            float hg[8] = {lo16(hv.x), hi16(hv.x), lo16(hv.y), hi16(hv.y), lo16(hv.z), hi16(hv.z), lo16(hv.w), hi16(hv.w)};
            u16* zp = Z + (size_t)(rowbase + b * LX + tc * 8) * DM + 512 + c;
#pragma unroll
            for (int j = 0; j < 8; ++j) zp[(size_t)j * DM] = f2bf(y[j] * g[j] * silu(hg[j]));
          }
        }
      }
    }
    __syncthreads();
  }
}

__device__ __forceinline__ void run_phase(const Params& p, int ph, unsigned char* smem, int only);
constexpr int LDS_BYTES = 77824;
__device__ __forceinline__ void run_phase(const Params& p, int ph, unsigned char* smem, int only) {
  const int nb = gridDim.x, bid = blockIdx.x;
#ifndef MIX_REP
#define MIX_REP 0
#endif
#ifndef PH_MASK
#define PH_MASK 0xff
#endif
  if (ph == 0) {
    if (PH_MASK & 1) for (int it = bid; it < 1938; it += nb) { if (it < 2) prep_softmax_shift(p, it, smem); else prep_item(p, 1937 - it, smem); }
    return;
  }
  const int layer = (ph - 1) / 5, sub = (ph - 1) % 5;
  if (sub == 0) {
    if (PH_MASK & 2) {
      if (nb == 512) {
        const int x = bid & 7, sl = bid >> 3;
        for (int k = sl; k < 288; k += 64) modulate_rows(p, layer, x * 288 + k);
      } else {
        for (int it = bid; it < MALL / 8; it += nb) modulate_rows(p, layer, it);
      }
    }
  } else if (sub == 1) {
    if (PH_MASK & 4) for (int it = bid; it < 64 * 32; it += nb) inproj_tile(p, layer, it, smem);
  } else if (sub == 2) {
    if (PH_MASK & 8) for (int it = bid; it < 576; it += nb) retkv_item(p, layer, it, smem);
  } else if (sub == 3) {
    const int half = nb >> 1;
    for (int step = 0;; ++step) {
      int kind = -1, idx = 0;
      if (bid < half) {
        const int i = bid + (step >> 1) * half;
        if (i >= 256) break;
        if (step & 1) { kind = 1; idx = 256 + i; } else { kind = 0; idx = ((i & 7) << 5) | (i >> 3); }
      } else {
        const int q = step / 6, sub = step - q * 6;
        const int j = (bid - half) + q * half;
        if (j >= 256) break;
        if (sub == 0) { kind = 1; idx = j; }
        else if (sub == 1) { if (layer == 0 && (j < 64 || j >= 128)) { kind = 2; idx = j; } }
        else if (sub == 2 || sub == 3) { const int r2 = 2 * j + (sub - 2); kind = 3; idx = (r2 >> 4) * 18 + (r2 & 15); }
        else if (sub == 4) { if (layer == 0 && j < 64) { kind = 1; idx = 512 + j; } else if (layer == 0 && j >= 128 && j < 192) { kind = 2; idx = j - 64; } }
        else { if (layer == 0 && j >= 64 && j < 128) { kind = 3; idx = ((j - 64) >> 1) * 18 + 16 + ((j - 64) & 1); } }
      }
      if (kind < 0) continue;
      if (only >= 0 && only != kind) continue;
      if (kind == 0) { if (PH_MASK & 16) hyena_item<SEQ, 8>(p, layer, idx, smem); }
      else if (kind == 1) { if (PH_MASK & 64) attn_item(p, layer, idx, smem); }
      else if (kind == 2) { if (PH_MASK & 16) hyena_item<LC, 1>(p, layer, idx, smem); }
      else { if (PH_MASK & 32) retout_item(p, layer, idx, smem); }
    }
  } else {
    if (PH_MASK & 128) {
      if (layer == 0) { for (int it = bid; it < 512; it += nb) outproj_tile<9>(p, layer, it, smem); }
      else { for (int it = bid; it < 512; it += nb) outproj_tile<8>(p, layer, it, smem); }
    }
  }
}

#define XB_TMO      128
#define XB_XCNT(j)  (256  + 64 * (j))
#define XB_XSUB(j)  (1280 + 64 * (j))
#define XB_XGEN(j)  (2304 + 64 * (j))
#define XB_TOP      3328
#define XB_TOPGEN   3392
#define XCD_BAR_WORDS 3456
#define XB_SPIN_CAP (1u << 22)
__device__ __forceinline__ unsigned xb_ld(unsigned* p)              { return __hip_atomic_load(p, __ATOMIC_RELAXED, __HIP_MEMORY_SCOPE_AGENT); }
__device__ __forceinline__ unsigned xb_add(unsigned* p, unsigned v) { return __hip_atomic_fetch_add(p, v, __ATOMIC_RELAXED, __HIP_MEMORY_SCOPE_AGENT); }
__device__ __forceinline__ unsigned xb_xcc_id() { return (unsigned)__builtin_amdgcn_s_getreg((3 << 11) | 20) & 0xFu; }
#define XB_SPIN(cond, bar) do { unsigned _sp = 0; while (cond) { __builtin_amdgcn_s_sleep(1); \
    if ((++_sp & 255u) == 0u) { if (xb_ld(&(bar)[XB_TMO])) break; if (_sp > XB_SPIN_CAP) { atomicAdd(&(bar)[XB_TMO], 1u); break; } } } } while (0)
struct XcdBarrier { unsigned* bar; unsigned x; volatile unsigned* st; };
__device__ __forceinline__ void xcd_barrier_complete(unsigned* bar, unsigned x, unsigned& nloc, unsigned& nx) {
  const unsigned G = gridDim.x * gridDim.y * gridDim.z;
  unsigned sum, cnt, mine, sp = 0u;
  for (;;) {
    sum = 0u; cnt = 0u; mine = 0u;
#pragma unroll
    for (unsigned j = 0; j < 16; ++j) { const unsigned c = xb_ld(&bar[XB_XCNT(j)]); sum += c; cnt += (c > 0u) ? 1u : 0u; mine = (j == x) ? c : mine; }
    if (sum == G) break;
    __builtin_amdgcn_s_sleep(1);
    if ((++sp & 255u) == 0u) { if (xb_ld(&bar[XB_TMO])) break; if (sp > XB_SPIN_CAP) { atomicAdd(&bar[XB_TMO], 1u); break; } }
  }
  nloc = mine > 0u ? mine : 1u; nx = cnt > 0u ? cnt : 1u;
}
__device__ __forceinline__ void xcd_barrier(XcdBarrier& b) {
  asm volatile("s_waitcnt vmcnt(0)" ::: "memory");
  __syncthreads();
  if (threadIdx.x == 0) {
    unsigned* bar = b.bar;
    __builtin_amdgcn_s_waitcnt(0);
    unsigned nloc = b.st[0], nx = b.st[1];
    if (nloc == 0u) { xcd_barrier_complete(bar, b.x, nloc, nx); b.st[0] = nloc; b.st[1] = nx; }
    const unsigned old = xb_add(&bar[XB_XSUB(b.x)], 1u);
    const unsigned gen = old / nloc;
    if (old + 1u == (gen + 1u) * nloc) {
      __builtin_amdgcn_fence(__ATOMIC_RELEASE, "agent");
      asm volatile("s_waitcnt vmcnt(0)" ::: "memory");
      const unsigned og = xb_add(&bar[XB_TOP], 1u);
      const unsigned tg = og / nx;
      if (og + 1u == (tg + 1u) * nx) xb_add(&bar[XB_TOPGEN], 1u);
      else XB_SPIN(xb_ld(&bar[XB_TOPGEN]) == tg, bar);
      __builtin_amdgcn_fence(__ATOMIC_ACQUIRE, "agent");
      xb_add(&bar[XB_XGEN(b.x)], 1u);
      asm volatile("s_waitcnt vmcnt(0)" ::: "memory");
    } else {
      XB_SPIN(xb_ld(&bar[XB_XGEN(b.x)]) == gen, bar);
      __builtin_amdgcn_fence(__ATOMIC_ACQUIRE, "agent");
      asm volatile("s_waitcnt vmcnt(0)" ::: "memory");
    }
  }
  __syncthreads();
}

constexpr int NPHASE = 11;

__global__ void __launch_bounds__(256, 2) mega_kernel(Params p, int ph_lo, int ph_hi, int use_cg) {
  extern __shared__ __attribute__((aligned(16))) unsigned char smem[];
  XcdBarrier xb;
  xb.bar = reinterpret_cast<unsigned*>(p.ws + OFF_BAR); xb.x = xb_xcc_id(); xb.st = reinterpret_cast<volatile unsigned*>(smem + LDS_BYTES - 16);
  if (threadIdx.x == 0) { xb.st[0] = 0u; xb.st[1] = 0u; }
  __syncthreads();
  if (!use_cg && ph_hi - ph_lo > 1 && threadIdx.x == 0) (void)xb_add(&xb.bar[XB_XCNT(xb.x)], 1u);
  for (int ph = ph_lo; ph < ph_hi; ++ph) {
    int nrep = 1;
#ifdef REP_MASK
    {
      int kind = (ph == 0) ? 0 : 1 + (ph - 1) % 5;
      if (((REP_MASK >> kind) & 1) && !(kind == 5 && ph > 5)) nrep = 2;
    }
#endif
#ifndef REP_ONLY
#define REP_ONLY -1
#endif
#pragma unroll 1
    for (int rep = 0; rep < nrep; ++rep) run_phase(p, ph, smem, rep == 0 ? -1 : REP_ONLY);
    if (ph + 1 < ph_hi) {
      if (use_cg) cg::this_grid().sync();
      else xcd_barrier(xb);
    }
  }
}

extern "C" void kernel_launch(void* const* d_in, const int* in_sizes, int n_in, void* d_out, int out_size, void* d_ws, size_t ws_size,
                              hipStream_t stream) {
  static int grid_blocks = 0;
  if (!grid_blocks) {
    int dev = 0, cus = 0, per_cu = 0;
    hipGetDevice(&dev);
    hipDeviceGetAttribute(&cus, hipDeviceAttributeMultiprocessorCount, dev);
    hipFuncSetAttribute((const void*)mega_kernel, hipFuncAttributeMaxDynamicSharedMemorySize, LDS_BYTES);
    hipOccupancyMaxActiveBlocksPerMultiprocessor(&per_cu, mega_kernel, 256, LDS_BYTES);
    if (per_cu < 1) per_cu = 1;
    if (per_cu > 2) per_cu = 2;
    grid_blocks = cus * per_cu;
    if (ws_size < WS_END) fprintf(stderr, "kernel_launch: workspace too small (%zu < %zu)\n", ws_size, (size_t)WS_END);
  }
  Params p{};
  const float** pp = reinterpret_cast<const float**>(&p);
  for (int i = 0; i < 22; ++i) pp[i] = (const float*)d_in[i];
  p.out = (float*)d_out;
  p.ws = (unsigned char*)d_ws;
#if COOP
  hipMemsetAsync((unsigned char*)d_ws + OFF_BAR, 0, 16384, stream);
  int lo = 0, hi = NPHASE, ucg = 0;
  void* args[] = {&p, &lo, &hi, &ucg};
  hipError_t e = hipLaunchCooperativeKernel((void*)mega_kernel, dim3(grid_blocks), dim3(256), args, LDS_BYTES, stream);
  if (e != hipSuccess) fprintf(stderr, "cooperative launch failed: %s (grid %d)\n", hipGetErrorString(e), grid_blocks);
#else
  for (int ph = 0; ph < NPHASE; ++ph) hipLaunchKernelGGL(mega_kernel, dim3(grid_blocks), dim3(256), LDS_BYTES, stream, p, ph, ph + 1, 0);
#endif
}
```
